# Optimizing an MI355X kernel written in HIP

```python
import jax, jax.numpy as jnp
from jax import lax
import numpy as np

D_MODEL = 1024
BATCH = 8
SEQ = 4096
DEPTH = 2

D_MIX = D_MODEL
ATTN_WIDTH = D_MIX // 2
REC_WIDTH = D_MIX - ATTN_WIDTH
HEAD_DIM = 64
N_HEADS = ATTN_WIDTH // HEAD_DIM
ROT_DIM = HEAD_DIM // 4
ROPE_THETA = 500000.0
MOBA_BLOCK = 256
MOBA_TOPK = 3
Q_CHUNK = 32
REC_BLOCKS = 8
REC_BLOCK = REC_WIDTH // REC_BLOCKS
CONV_WIDTH = 4
LRU_C = 8.0
N_GROUPS = 4
EXPERTS_PER_GROUP = 4
N_EXPERTS = N_GROUPS * EXPERTS_PER_GROUP
MOE_TOPK = 2
D_EXPERT = 512
IN_PROJ_WIDTH = 3 * ATTN_WIDTH + 2 * REC_WIDTH
DEEPNORM_ALPHA = (2 * DEPTH) ** 0.25
DEEPNORM_BETA = (8 * DEPTH) ** -0.25
LN_EPS = 1e-5
RMS_EPS = 1e-6

kernel_name = 'hymba_moba_rglru_hmoe_deepnorm'

F32 = jnp.float32


def _layer_norm(x, g, b):
    xf = x.astype(F32)
    mu = jnp.mean(xf, axis=-1, keepdims=True)
    var = jnp.mean(jnp.square(xf - mu), axis=-1, keepdims=True)
    return ((xf - mu) * lax.rsqrt(var + LN_EPS) * g.astype(F32) + b.astype(F32)).astype(x.dtype)


def _rms_norm(x, g):
    xf = x.astype(F32)
    return (xf * lax.rsqrt(jnp.mean(xf * xf, axis=-1, keepdims=True) + RMS_EPS) * g.astype(F32)).astype(x.dtype)


def _partial_rope(t, pos):
    half = ROT_DIM // 2
    inv_freq = ROPE_THETA ** (-jnp.arange(half, dtype=F32) * 2.0 / ROT_DIM)
    ang = pos.astype(F32)[:, None] * inv_freq[None, :]
    cos = jnp.cos(ang).astype(t.dtype)
    sin = jnp.sin(ang).astype(t.dtype)
    t1 = t[..., :half]
    t2 = t[..., half:ROT_DIM]
    rest = t[..., ROT_DIM:]
    return jnp.concatenate([t1 * cos - t2 * sin, t2 * cos + t1 * sin, rest], axis=-1)


def _moba_attention(q, k, v):
    B, H, S, Dh = q.shape
    nb = S // MOBA_BLOCK
    k_sel = min(MOBA_TOPK, nb)
    kb = k.reshape(B, H, nb, MOBA_BLOCK, Dh)
    vb = v.reshape(B, H, nb, MOBA_BLOCK, Dh)
    kmean = jnp.mean(kb.astype(F32), axis=3).astype(k.dtype)
    scale = HEAD_DIM ** -0.5
    b_ix = jnp.arange(B)[:, None, None, None]
    h_ix = jnp.arange(H)[None, :, None, None]
    blk_ids = jnp.arange(nb)
    rank = jnp.arange(k_sel)

    def chunk(c):
        q0 = c * Q_CHUNK
        bi = q0 // MOBA_BLOCK
        qc = lax.dynamic_slice_in_dim(q, q0, Q_CHUNK, axis=2)
        qpos = q0 + jnp.arange(Q_CHUNK)
        k_own = lax.dynamic_slice_in_dim(k, bi * MOBA_BLOCK, MOBA_BLOCK, axis=2)
        v_own = lax.dynamic_slice_in_dim(v, bi * MOBA_BLOCK, MOBA_BLOCK, axis=2)
        kpos = bi * MOBA_BLOCK + jnp.arange(MOBA_BLOCK)
        s_own = jnp.einsum('bhqd,bhkd->bhqk', qc, k_own).astype(F32) * scale
        s_own = jnp.where(kpos[None, :] <= qpos[:, None], s_own, -jnp.inf)
        gate = jnp.einsum('bhqd,bhnd->bhqn', qc, kmean).astype(F32)
        gate = jnp.where(blk_ids < bi, gate, -jnp.inf)
        _, sel = lax.top_k(gate, k_sel)
        k_g = kb[b_ix, h_ix, sel]
        v_g = vb[b_ix, h_ix, sel]
        s_past = jnp.einsum('bhqd,bhqjkd->bhqjk', qc, k_g).astype(F32) * scale
        s_past = jnp.where((rank < bi)[:, None], s_past, -jnp.inf)
        s_past = s_past.reshape(B, H, Q_CHUNK, k_sel * MOBA_BLOCK)
        p = jax.nn.softmax(jnp.concatenate([s_past, s_own], axis=-1), axis=-1).astype(v.dtype)
        p_past = p[..., :k_sel * MOBA_BLOCK].reshape(B, H, Q_CHUNK, k_sel, MOBA_BLOCK)
        p_own = p[..., k_sel * MOBA_BLOCK:]
        return (jnp.einsum('bhqjk,bhqjkd->bhqd', p_past, v_g)
                + jnp.einsum('bhqk,bhkd->bhqd', p_own, v_own))

    out = lax.map(chunk, jnp.arange(S // Q_CHUNK))
    return jnp.moveaxis(out, 0, 2).reshape(B, H, S, Dh)


def _rglru_branch(xr, gr, conv_w, conv_b, w_a, b_a, w_i, b_i, lam):
    B, S, R = xr.shape
    xc = lax.conv_general_dilated(
        xr, conv_w[:, None, :], window_strides=(1,), padding=[(CONV_WIDTH - 1, 0)],
        dimension_numbers=('NWC', 'WIO', 'NWC'), feature_group_count=R) + conv_b
    xb = xc.reshape(B, S, REC_BLOCKS, REC_BLOCK)
    r = jax.nn.sigmoid(jnp.einsum('bsnc,ncd->bsnd', xb, w_a).reshape(B, S, R) + b_a)
    i = jax.nn.sigmoid(jnp.einsum('bsnc,ncd->bsnd', xb, w_i).reshape(B, S, R) + b_i)
    log_a = (-LRU_C * r.astype(F32)) * jax.nn.softplus(-lam.astype(F32))
    a = jnp.exp(log_a)
    u = jnp.sqrt(-jnp.expm1(2.0 * log_a)) * (i * xc).astype(F32)

    def combine(e1, e2):
        a1, b1 = e1
        a2, b2 = e2
        return a1 * a2, a2 * b1 + b2

    _, h = lax.associative_scan(combine, (a, u), axis=1)
    return h.astype(xr.dtype) * jax.nn.gelu(gr)


def _hybrid_mixer(x, w_in, conv_w, conv_b, w_rg_a, b_rg_a, w_rg_i, b_rg_i, lru_lambda,
                  g_attn_norm, g_rec_norm, w_out):
    B, S, _ = x.shape
    proj = x @ w_in
    q, k, v, xr, gr = jnp.split(
        proj, [ATTN_WIDTH, 2 * ATTN_WIDTH, 3 * ATTN_WIDTH, 3 * ATTN_WIDTH + REC_WIDTH], axis=-1)
    s_pad = -(-S // MOBA_BLOCK) * MOBA_BLOCK

    def heads(t):
        t = t.reshape(B, S, N_HEADS, HEAD_DIM).transpose(0, 2, 1, 3)
        return jnp.pad(t, ((0, 0), (0, 0), (0, s_pad - S), (0, 0)))

    pos = jnp.arange(s_pad)
    qh = _partial_rope(heads(q), pos)
    kh = _partial_rope(heads(k), pos)
    vh = heads(v)
    attn = _moba_attention(qh, kh, vh)[:, :, :S].transpose(0, 2, 1, 3).reshape(B, S, ATTN_WIDTH)
    rec = _rglru_branch(xr, gr, conv_w, conv_b, w_rg_a, b_rg_a, w_rg_i, b_rg_i, lru_lambda)
    mixed = jnp.concatenate([_rms_norm(attn, g_attn_norm), _rms_norm(rec, g_rec_norm)], axis=-1)
    return mixed @ w_out


def _hier_moe(x, w_router_group, b_router_group, w_router_expert, b_router_expert,
              w_gate, w_up, w_down):
    B, S, D = x.shape
    xt = x.reshape(-1, D)
    T = xt.shape[0]
    g_prob = jax.nn.softmax((xt @ w_router_group).astype(F32) + b_router_group.astype(F32), axis=-1)
    g_p, g_idx = lax.top_k(g_prob, 1)
    e_logits = ((xt @ w_router_expert).astype(F32) + b_router_expert.astype(F32)).reshape(
        T, N_GROUPS, EXPERTS_PER_GROUP)
    e_logits = e_logits[jnp.arange(T), g_idx[:, 0]]
    e_p, e_idx = lax.top_k(jax.nn.softmax(e_logits, axis=-1), MOE_TOPK)
    wts = g_p * e_p / jnp.sum(e_p, axis=-1, keepdims=True)
    eid = g_idx * EXPERTS_PER_GROUP + e_idx
    comb = jnp.sum(jax.nn.one_hot(eid, N_EXPERTS, dtype=F32) * wts[..., None], axis=1).astype(x.dtype)
    y = jnp.zeros_like(xt)
    for e in range(N_EXPERTS):
        h = jax.nn.silu(xt @ w_gate[e]) * (xt @ w_up[e])
        y = y + comb[:, e:e + 1] * (h @ w_down[e])
    return y.reshape(B, S, D)


def setup_inputs(seed: int = 0) -> dict:
    key = jax.random.key(seed)
    ks = jax.random.split(key, 24)
    nrm = lambda k, shape, s: jax.random.normal(k, shape, F32) * s
    a_c = jax.random.uniform(ks[8], (DEPTH, REC_WIDTH), F32, minval=0.9, maxval=0.999)
    s_lam = a_c ** (1.0 / LRU_C)
    return {
        'x': nrm(ks[0], (BATCH, SEQ, D_MODEL), 1.0),
        'w_in': nrm(ks[1], (DEPTH, D_MODEL, IN_PROJ_WIDTH), D_MODEL ** -0.5),
        'conv_w': nrm(ks[2], (DEPTH, CONV_WIDTH, REC_WIDTH), CONV_WIDTH ** -0.5),
        'conv_b': nrm(ks[3], (DEPTH, REC_WIDTH), 0.01),
        'w_rg_a': nrm(ks[4], (DEPTH, REC_BLOCKS, REC_BLOCK, REC_BLOCK), REC_BLOCK ** -0.5),
        'b_rg_a': nrm(ks[5], (DEPTH, REC_WIDTH), 0.01),
        'w_rg_i': nrm(ks[6], (DEPTH, REC_BLOCKS, REC_BLOCK, REC_BLOCK), REC_BLOCK ** -0.5),
        'b_rg_i': nrm(ks[7], (DEPTH, REC_WIDTH), 0.01),
        'lru_lambda': jnp.log(s_lam) - jnp.log1p(-s_lam),
        'g_attn_norm': 1.0 + nrm(ks[9], (DEPTH, ATTN_WIDTH), 0.02),
        'g_rec_norm': 1.0 + nrm(ks[10], (DEPTH, REC_WIDTH), 0.02),
        'w_out': nrm(ks[11], (DEPTH, D_MIX, D_MODEL), D_MIX ** -0.5 * DEEPNORM_BETA),
        'ln1_g': 1.0 + nrm(ks[12], (DEPTH, D_MODEL), 0.02),
        'ln1_b': nrm(ks[13], (DEPTH, D_MODEL), 0.01),
        'w_router_group': nrm(ks[14], (DEPTH, D_MODEL, N_GROUPS), D_MODEL ** -0.5),
        'b_router_group': nrm(ks[15], (DEPTH, N_GROUPS), 0.01),
        'w_router_expert': nrm(ks[16], (DEPTH, D_MODEL, N_EXPERTS), D_MODEL ** -0.5),
        'b_router_expert': nrm(ks[17], (DEPTH, N_EXPERTS), 0.01),
        'w_gate': nrm(ks[18], (DEPTH, N_EXPERTS, D_MODEL, D_EXPERT), D_MODEL ** -0.5),
        'w_up': nrm(ks[19], (DEPTH, N_EXPERTS, D_MODEL, D_EXPERT), D_MODEL ** -0.5),
        'w_down': nrm(ks[20], (DEPTH, N_EXPERTS, D_EXPERT, D_MODEL), D_EXPERT ** -0.5 * DEEPNORM_BETA),
        'ln2_g': 1.0 + nrm(ks[21], (DEPTH, D_MODEL), 0.02),
        'ln2_b': nrm(ks[22], (DEPTH, D_MODEL), 0.01),
    }


def reference(x, w_in, conv_w, conv_b, w_rg_a, b_rg_a, w_rg_i, b_rg_i, lru_lambda,
              g_attn_norm, g_rec_norm, w_out, ln1_g, ln1_b, w_router_group, b_router_group,
              w_router_expert, b_router_expert, w_gate, w_up, w_down, ln2_g, ln2_b):
    for l in range(DEPTH):
        h = _hybrid_mixer(x, w_in[l], conv_w[l], conv_b[l], w_rg_a[l], b_rg_a[l], w_rg_i[l],
                          b_rg_i[l], lru_lambda[l], g_attn_norm[l], g_rec_norm[l], w_out[l])
        x = _layer_norm(DEEPNORM_ALPHA * x + h, ln1_g[l], ln1_b[l])
        h = _hier_moe(x, w_router_group[l], b_router_group[l], w_router_expert[l],
                      b_router_expert[l], w_gate[l], w_up[l], w_down[l])
        x = _layer_norm(DEEPNORM_ALPHA * x + h, ln2_g[l], ln2_b[l])
    return x
```

```cpp
#include <hip/hip_runtime.h>
#include <cstdio>
#include <cstdint>
#include <cmath>
namespace nv {
constexpr int NB = 8, NS = 4096, ND = 1024, NT = NB * NS, NH = 8, NHD = 64, NBLK = 16;
constexpr float ALPHA = 1.41421356237309515f;

template <int MODE>
__global__ __launch_bounds__(256) void gemm_f32(const float* __restrict__ A, int lda, const int* __restrict__ rowidx, const int* __restrict__ cntp, int Mmax,
                                                const float* __restrict__ B0, const float* __restrict__ B1, int ldb, float* C, int ldc, int N, int K,
                                                const float* __restrict__ roww) {
    const int M = cntp ? *cntp : Mmax;
    const int m0 = blockIdx.y * 64, n0 = blockIdx.x * 64;
    if (m0 >= M) return;
    __shared__ float As[16][65];
    __shared__ float Bs[16][64];
    __shared__ float Bs1[MODE == 1 ? 16 : 1][64];
    const int tid = threadIdx.x, tx = tid & 15, ty = tid >> 4;
    float acc[4][4] = {}, acc1[4][4] = {};
    const int ar = tid >> 2, ak = (tid & 3) * 4;
    const int arow = m0 + ar;
    const bool avalid = arow < M;
    const long asrc = avalid ? (long)((MODE != 2 && rowidx) ? rowidx[arow] : arow) * lda : 0;
    const int bk = tid >> 4, bn = (tid & 15) * 4;
    for (int k0 = 0; k0 < K; k0 += 16) {
        float4 av = avalid ? *(const float4*)(A + asrc + k0 + ak) : make_float4(0.f, 0.f, 0.f, 0.f);
        As[ak + 0][ar] = av.x; As[ak + 1][ar] = av.y; As[ak + 2][ar] = av.z; As[ak + 3][ar] = av.w;
        *(float4*)&Bs[bk][bn] = *(const float4*)(B0 + (long)(k0 + bk) * ldb + n0 + bn);
        if (MODE == 1) *(float4*)&Bs1[bk][bn] = *(const float4*)(B1 + (long)(k0 + bk) * ldb + n0 + bn);
        __syncthreads();
#pragma unroll
        for (int k = 0; k < 16; ++k) {
            float a[4], b[4], b1[4];
#pragma unroll
            for (int j = 0; j < 4; ++j) { a[j] = As[k][ty * 4 + j]; b[j] = Bs[k][tx * 4 + j]; if (MODE == 1) b1[j] = Bs1[k][tx * 4 + j]; }
#pragma unroll
            for (int j = 0; j < 4; ++j)
#pragma unroll
                for (int l = 0; l < 4; ++l) { acc[j][l] += a[j] * b[l]; if (MODE == 1) acc1[j][l] += a[j] * b1[l]; }
        }
        __syncthreads();
    }
#pragma unroll
    for (int j = 0; j < 4; ++j) {
        const int r = m0 + ty * 4 + j;
        if (r >= M) continue;
        if (MODE == 2) {
            const int tok = rowidx[r]; const float w = roww[r];
#pragma unroll
            for (int l = 0; l < 4; ++l) atomicAdd(&C[(long)tok * ldc + n0 + tx * 4 + l], w * acc[j][l]);
        } else {
            float4 o;
            if (MODE == 1) {
                float t[4];
#pragma unroll
                for (int l = 0; l < 4; ++l) { const float g = acc[j][l]; t[l] = g / (1.f + expf(-g)) * acc1[j][l]; }
                o = make_float4(t[0], t[1], t[2], t[3]);
            } else o = make_float4(acc[j][0], acc[j][1], acc[j][2], acc[j][3]);
            *(float4*)(C + (long)r * ldc + n0 + tx * 4) = o;
        }
    }
}

__global__ void rope_f32(float* buf) {
    const long i = (long)blockIdx.x * blockDim.x + threadIdx.x;
    if (i >= (long)NT * NH * 8) return;
    const int j = (int)(i & 7), h = (int)((i >> 3) & 7); const long t = i >> 6; const int s = (int)(t % NS);
    const float inv = powf(500000.0f, -(float)j / 8.0f);
    const float ang = (float)s * inv;
    const float c = cosf(ang), sn = sinf(ang);
    float* p = buf + t * 512 + h * 64 + j;
    const float a = p[0], b = p[8];
    p[0] = a * c - b * sn; p[8] = b * c + a * sn;
}
__global__ void kmean_f32(const float* __restrict__ k, float* __restrict__ km) {
    const int i = blockIdx.x * blockDim.x + threadIdx.x; if (i >= NB * NH * NBLK * NHD) return;
    const int d = i & 63, blk = (i >> 6) & 15, h = (i >> 10) & 7, b = i >> 13;
    float s = 0.f;
    for (int r = 0; r < 256; ++r) s += k[((long)b * NS + blk * 256 + r) * 512 + h * 64 + d];
    km[i] = s * (1.f / 256.f);
}
__device__ __forceinline__ float wsum(float v) { for (int o = 32; o; o >>= 1) v += __shfl_xor(v, o); return v; }
__device__ __forceinline__ float wmax(float v) { for (int o = 32; o; o >>= 1) v = fmaxf(v, __shfl_xor(v, o)); return v; }
__global__ __launch_bounds__(64) void attn_f32(const float* q, const float* __restrict__ k, const float* __restrict__ v, const float* __restrict__ km, float* out) {
    const int idx = blockIdx.x, h = idx & 7; const int t = idx >> 3, b = t / NS, s = t % NS, bi = s >> 8, lane = threadIdx.x;
    __shared__ float qs[64]; __shared__ float ps[1024]; __shared__ int sel[3]; __shared__ float gate[16];
    qs[lane] = q[(long)t * 512 + h * 64 + lane];
    __syncthreads();
    if (lane < 16) {
        float g = -INFINITY;
        if (lane < bi) { g = 0.f; const float* kp = km + ((b * NH + h) * NBLK + lane) * 64; for (int d = 0; d < 64; ++d) g += qs[d] * kp[d]; }
        gate[lane] = g;
    }
    __syncthreads();
    if (lane == 0) {
        unsigned used = 0u;
        for (int r = 0; r < 3; ++r) { int best = -1; float bv = -INFINITY;
            for (int j = 0; j < 16; ++j) if (!((used >> j) & 1u) && (best < 0 || gate[j] > bv)) { best = j; bv = gate[j]; }
            used |= 1u << best; sel[r] = best; }
    }
    __syncthreads();
    const int nblk = bi < 3 ? bi : 3;
    float mx = -INFINITY;
    for (int j = 0; j < 4; ++j) {
        const int blk = (j < 3) ? sel[j] : bi; const bool valid = (j < 3) ? (j < nblk) : true;
        for (int i = 0; i < 4; ++i) {
            const int key = blk * 256 + i * 64 + lane; float sc = -INFINITY;
            if (valid && !(j == 3 && key > s)) { const float* kp = k + ((long)b * NS + key) * 512 + h * 64; float a = 0.f; for (int d = 0; d < 64; ++d) a += qs[d] * kp[d]; sc = a * 0.125f; }
            ps[j * 256 + i * 64 + lane] = sc; mx = fmaxf(mx, sc);
        }
    }
    mx = wmax(mx);
    float sum = 0.f;
    for (int e = lane; e < 1024; e += 64) { const float p = (ps[e] == -INFINITY) ? 0.f : expf(ps[e] - mx); ps[e] = p; sum += p; }
    sum = wsum(sum);
    __syncthreads();
    const float inv = 1.f / sum; float acc = 0.f;
    for (int j = 0; j < 4; ++j) {
        const int blk = (j < 3) ? sel[j] : bi; const bool valid = (j < 3) ? (j < nblk) : true;
        if (!valid) continue;
        for (int i = 0; i < 256; ++i) { const float p = ps[j * 256 + i]; if (p != 0.f) acc += p * v[((long)b * NS + blk * 256 + i) * 512 + h * 64 + lane]; }
    }
    out[(long)t * 512 + h * 64 + lane] = acc * inv;
}
__global__ __launch_bounds__(64) void rglru_gates_f32(const float* __restrict__ xr, const float* __restrict__ conv_w, const float* __restrict__ conv_b,
                                                      const float* __restrict__ w_a, const float* __restrict__ b_a, const float* __restrict__ w_i, const float* __restrict__ b_i,
                                                      const float* __restrict__ lam, float* __restrict__ Aout, float* __restrict__ Uout) {
    const int n = blockIdx.x & 7; const long t = blockIdx.x >> 3; const int c = threadIdx.x, ch = n * 64 + c, s = (int)(t % NS);
    float xc = conv_b[ch];
    for (int w = 0; w < 4; ++w) { const int sp = s - 3 + w; if (sp >= 0) xc += conv_w[w * 512 + ch] * xr[(t - 3 + w) * 512 + ch]; }
    __shared__ float xs[64]; xs[c] = xc; __syncthreads();
    float ra = b_a[ch], ri = b_i[ch];
    for (int cc = 0; cc < 64; ++cc) { ra += xs[cc] * w_a[(n * 64 + cc) * 64 + c]; ri += xs[cc] * w_i[(n * 64 + cc) * 64 + c]; }
    const float r = 1.f / (1.f + expf(-ra)), ig = 1.f / (1.f + expf(-ri));
    const float la = -8.0f * r * log1pf(expf(-lam[ch]));
    Aout[t * 512 + ch] = expf(la);
    Uout[t * 512 + ch] = sqrtf(-expm1f(2.f * la)) * (ig * xc);
}
__device__ __forceinline__ float gelu_tanh(float x) { return 0.5f * x * (1.f + tanhf(0.7978845608028654f * (x + 0.044715f * x * x * x))); }
__global__ void rglru_scan_f32(const float* __restrict__ Aa, float* U, const float* __restrict__ gr) {
    const int i = blockIdx.x * blockDim.x + threadIdx.x; if (i >= NB * 512) return;
    const int b = i >> 9, ch = i & 511; float h = 0.f; long base = (long)b * NS * 512 + ch;
    for (int s0 = 0; s0 < NS; s0 += 8) {
        float a[8], u[8], g[8];
#pragma unroll
        for (int j = 0; j < 8; ++j) { a[j] = Aa[base + (long)(s0 + j) * 512]; u[j] = U[base + (long)(s0 + j) * 512]; g[j] = gr[base + (long)(s0 + j) * 512]; }
#pragma unroll
        for (int j = 0; j < 8; ++j) { h = a[j] * h + u[j]; U[base + (long)(s0 + j) * 512] = h * gelu_tanh(g[j]); }
    }
}
__global__ __launch_bounds__(256) void rms_concat_f32(const float* __restrict__ attn, const float* __restrict__ rec, const float* __restrict__ ga, const float* __restrict__ gr, float* __restrict__ mixed) {
    const int t = blockIdx.x * 4 + (threadIdx.x >> 6), lane = threadIdx.x & 63;
    float a[8], r[8], sa = 0.f, sr = 0.f;
#pragma unroll
    for (int j = 0; j < 8; ++j) { a[j] = attn[(long)t * 512 + j * 64 + lane]; r[j] = rec[(long)t * 512 + j * 64 + lane]; sa += a[j] * a[j]; sr += r[j] * r[j]; }
    sa = wsum(sa); sr = wsum(sr);
    const float ia = rsqrtf(sa * (1.f / 512.f) + 1e-6f), ir = rsqrtf(sr * (1.f / 512.f) + 1e-6f);
#pragma unroll
    for (int j = 0; j < 8; ++j) { mixed[(long)t * 1024 + j * 64 + lane] = a[j] * ia * ga[j * 64 + lane]; mixed[(long)t * 1024 + 512 + j * 64 + lane] = r[j] * ir * gr[j * 64 + lane]; }
}
__global__ __launch_bounds__(256) void ln_res_f32(const float* __restrict__ xin, const float* h, const float* __restrict__ g, const float* __restrict__ bb, float* out) {
    const int t = blockIdx.x * 4 + (threadIdx.x >> 6), lane = threadIdx.x & 63;
    float v[16], s = 0.f;
#pragma unroll
    for (int j = 0; j < 16; ++j) { v[j] = ALPHA * xin[(long)t * 1024 + j * 64 + lane] + h[(long)t * 1024 + j * 64 + lane]; s += v[j]; }
    const float mu = wsum(s) * (1.f / 1024.f); float q = 0.f;
#pragma unroll
    for (int j = 0; j < 16; ++j) { v[j] -= mu; q += v[j] * v[j]; }
    const float rstd = rsqrtf(wsum(q) * (1.f / 1024.f) + 1e-5f);
#pragma unroll
    for (int j = 0; j < 16; ++j) out[(long)t * 1024 + j * 64 + lane] = v[j] * rstd * g[j * 64 + lane] + bb[j * 64 + lane];
}
__global__ __launch_bounds__(256) void router_f32(const float* __restrict__ x, const float* __restrict__ wg, const float* __restrict__ bg, const float* __restrict__ we, const float* __restrict__ be,
                                                  int* cnt, int* list_tok, float* list_w) {
    const int t = blockIdx.x * 4 + (threadIdx.x >> 6), lane = threadIdx.x & 63;
    float lg[4] = {}, le[16] = {};
    for (int j = 0; j < 16; ++j) { const int c = j * 64 + lane; const float xv = x[(long)t * 1024 + c];
#pragma unroll
        for (int o = 0; o < 4; ++o) lg[o] += xv * wg[c * 4 + o];
#pragma unroll
        for (int o = 0; o < 16; ++o) le[o] += xv * we[c * 16 + o]; }
#pragma unroll
    for (int o = 0; o < 4; ++o) lg[o] = wsum(lg[o]) + bg[o];
#pragma unroll
    for (int o = 0; o < 16; ++o) le[o] = wsum(le[o]) + be[o];
    int gi = 0; float gv = lg[0];
#pragma unroll
    for (int o = 1; o < 4; ++o) if (lg[o] > gv) { gi = o; gv = lg[o]; }
    float gs = 0.f;
#pragma unroll
    for (int o = 0; o < 4; ++o) gs += expf(lg[o] - gv);
    const float gp = 1.f / gs;
    float l4[4];
#pragma unroll
    for (int o = 0; o < 4; ++o) l4[o] = gi == 0 ? le[o] : gi == 1 ? le[4 + o] : gi == 2 ? le[8 + o] : le[12 + o];
    int e0 = 0; float v0 = l4[0];
#pragma unroll
    for (int o = 1; o < 4; ++o) if (l4[o] > v0) { e0 = o; v0 = l4[o]; }
    int e1 = -1; float v1 = -INFINITY;
#pragma unroll
    for (int o = 0; o < 4; ++o) if (o != e0 && (e1 < 0 || l4[o] > v1)) { e1 = o; v1 = l4[o]; }
    const float p1 = expf(v1 - v0);
    const float w0 = gp / (1.f + p1), w1 = gp * p1 / (1.f + p1);
    if (lane == 0) {
        const int E0 = gi * 4 + e0, E1 = gi * 4 + e1;
        int p = atomicAdd(&cnt[E0], 1); list_tok[E0 * NT + p] = t; list_w[E0 * NT + p] = w0;
        p = atomicAdd(&cnt[E1], 1); list_tok[E1 * NT + p] = t; list_w[E1 * NT + p] = w1;
    }
}

struct Ptrs { const float* in[23]; };
constexpr size_t MiB = 1u << 20;
inline void forward(const Ptrs& P, float* d_out, unsigned char* ws, hipStream_t st) {
    float* XA = (float*)(ws);
    float* R1 = (float*)(ws + 128 * MiB);
    unsigned char* S = ws + 256 * MiB;
    float* Sq = (float*)(S), *Sk = (float*)(S + 64 * MiB), *Sv = (float*)(S + 128 * MiB), *Sx = (float*)(S + 192 * MiB);
    for (int l = 0; l < 2; ++l) {
        const float* xin = l == 0 ? P.in[0] : XA;
        const float* w_in = P.in[1] + (size_t)l * 1024 * 2560;
        auto proj = [&](int part, float* dst) { gemm_f32<0><<<dim3(512 / 64, NT / 64), 256, 0, st>>>(xin, 1024, nullptr, nullptr, NT, w_in + part * 512, nullptr, 2560, dst, 512, 512, 1024, nullptr); };
        proj(0, Sq); proj(1, Sk); proj(2, Sv);
        rope_f32<<<(NT * 64 + 255) / 256, 256, 0, st>>>(Sq);
        rope_f32<<<(NT * 64 + 255) / 256, 256, 0, st>>>(Sk);
        float* km = Sx;
        kmean_f32<<<(NB * NH * NBLK * NHD) / 256, 256, 0, st>>>(Sk, km);
        attn_f32<<<NT * NH, 64, 0, st>>>(Sq, Sk, Sv, km, Sq);
        proj(3, Sk); proj(4, Sv);
        float* Aa = Sx; float* U = R1;
        rglru_gates_f32<<<NT * 8, 64, 0, st>>>(Sk, P.in[2] + l * 2048, P.in[3] + l * 512, P.in[4] + l * 32768, P.in[5] + l * 512, P.in[6] + l * 32768, P.in[7] + l * 512, P.in[8] + l * 512, Aa, U);
        rglru_scan_f32<<<(NB * 512) / 256, 256, 0, st>>>(Aa, U, Sv);
        float* mixed = Sk;
        rms_concat_f32<<<NT / 4, 256, 0, st>>>(Sq, U, P.in[9] + l * 512, P.in[10] + l * 512, mixed);
        float* hb = R1;
        gemm_f32<0><<<dim3(1024 / 64, NT / 64), 256, 0, st>>>(mixed, 1024, nullptr, nullptr, NT, P.in[11] + (size_t)l * 1024 * 1024, nullptr, 1024, hb, 1024, 1024, 1024, nullptr);
        float* XM = R1;
        ln_res_f32<<<NT / 4, 256, 0, st>>>(xin, hb, P.in[12] + l * 1024, P.in[13] + l * 1024, XM);
        float* yacc = (float*)S; float* He = (float*)(S + 128 * MiB);
        int* list_tok = (int*)(S + 192 * MiB); float* list_w = (float*)(S + 194 * MiB); int* cnt = (int*)(S + 196 * MiB);
        (void)hipMemsetAsync(cnt, 0, 256, st);
        (void)hipMemsetAsync(yacc, 0, (size_t)NT * 1024 * 4, st);
        router_f32<<<NT / 4, 256, 0, st>>>(XM, P.in[14] + l * 4096, P.in[15] + l * 4, P.in[16] + l * 16384, P.in[17] + l * 16, cnt, list_tok, list_w);
        for (int e = 0; e < 16; ++e) {
            const float* wg = P.in[18] + ((size_t)l * 16 + e) * 1024 * 512, *wu = P.in[19] + ((size_t)l * 16 + e) * 1024 * 512, *wd = P.in[20] + ((size_t)l * 16 + e) * 512 * 1024;
            gemm_f32<1><<<dim3(512 / 64, NT / 64), 256, 0, st>>>(XM, 1024, list_tok + e * NT, cnt + e, NT, wg, wu, 512, He, 512, 512, 1024, nullptr);
            gemm_f32<2><<<dim3(1024 / 64, NT / 64), 256, 0, st>>>(He, 512, list_tok + e * NT, cnt + e, NT, wd, nullptr, 1024, yacc, 1024, 1024, 512, list_w + e * NT);
        }
        float* xo = l == 0 ? XA : d_out;
        ln_res_f32<<<NT / 4, 256, 0, st>>>(XM, yacc, P.in[21] + l * 1024, P.in[22] + l * 1024, xo);
    }
}
}
extern "C" void kernel_launch(void* const* d_in, const int* in_sizes, int n_in, void* d_out, int out_size, void* d_ws, size_t ws_size, hipStream_t stream) {
    if (n_in != 23 || ws_size < 512 * nv::MiB) { fprintf(stderr, "kernel_launch: unexpected n_in %d / ws_size %zu\n", n_in, ws_size); return; }
    nv::Ptrs P; for (int i = 0; i < 23; ++i) P.in[i] = (const float*)d_in[i];
    nv::forward(P, (float*)d_out, (unsigned char*)d_ws, stream);
}
```

```cpp
#include <hip/hip_runtime.h>
#include <cstdio>
#include <cstdint>
#include <cmath>

namespace cfg {
constexpr int NB = 8, NS = 4096, D = 1024, T = NB * NS, NPROJ = 2560, NH = 8, HD = 64, NBLK = 16, NEXP = 16, DEXP = 512;
constexpr int QOFF = 0, KOFF = 512, VOFF = 1024, XROFF = 1536, GROFF = 2048;
constexpr float ALPHA = 1.41421356237309515f;
constexpr float C2 = 0.125f * 1.4426950408889634f;
constexpr float LN_EPS = 1e-5f, RMS_EPS = 1e-6f;
constexpr size_t MiB = 1u << 20;
constexpr size_t WS_CTL = 0, CTL_ZERO_BYTES = 1 * MiB;
constexpr size_t WS_WIN = 2 * MiB;
constexpr size_t WS_WOUT = 12 * MiB;
constexpr size_t WS_WGU = 16 * MiB;
constexpr size_t WS_WD = 80 * MiB;
constexpr size_t WS_SMALL = 112 * MiB;
constexpr size_t WS_ROPE = WS_SMALL;
constexpr size_t WS_KM = WS_SMALL + 1 * MiB;
constexpr size_t WS_SUMM = WS_SMALL + 2 * MiB;
constexpr size_t WS_WRG = WS_SMALL + 3 * MiB;
constexpr size_t WS_SP = WS_SMALL + 3 * MiB + 512 * 1024;
constexpr size_t WS_SSQ = WS_SMALL + 4 * MiB;
constexpr size_t WS_TOK = WS_SMALL + 6 * MiB;
constexpr size_t WS_LIST = WS_SMALL + 8 * MiB;
constexpr size_t WS_XB = 128 * MiB;
constexpr size_t WS_PROJ = 192 * MiB;
constexpr size_t WS_MIX = 352 * MiB;
constexpr size_t WS_PRE = 416 * MiB;
constexpr size_t WS_X1 = 192 * MiB;
constexpr size_t WS_H = 256 * MiB;
constexpr size_t WS_Y = 324 * MiB;
constexpr size_t WS_END = 480 * MiB;
constexpr int MAXSLOT = 69632;
constexpr int CW_TMO = 0, CW_CODE = 1, CW_BAR = 4096, CW_CNT = 8192;
}

typedef unsigned short bf16;
__device__ __forceinline__ float bf2f(bf16 v) { return __uint_as_float((unsigned)v << 16); }
__device__ __forceinline__ unsigned f2bf(float f) { unsigned u = __builtin_bit_cast(unsigned, f); return (u + 0x7fffu + ((u >> 16) & 1u)) >> 16; }
__device__ __forceinline__ unsigned pk2(float lo, float hi) { return f2bf(lo) | (f2bf(hi) << 16); }
__device__ __forceinline__ float gelu_tanh_f(float x) { const float y = 0.7978845608028654f * (x + 0.044715f * x * x * x); return x / (1.f + __expf(-2.f * y)); }
#define MK_IMPL 0x1FFFF
#define MK_PARTS 7
#define MK_FUSE 1
namespace nb {
using namespace cfg;
__device__ __forceinline__ float wsum(float v) { for (int o = 32; o; o >>= 1) v += __shfl_xor(v, o); return v; }
__device__ __forceinline__ float wmax(float v) { for (int o = 32; o; o >>= 1) v = fmaxf(v, __shfl_xor(v, o)); return v; }

__global__ void x_to_bf16(const float* __restrict__ x, bf16* __restrict__ xb) {
    const size_t i = ((size_t)blockIdx.x * blockDim.x + threadIdx.x) * 4; if (i >= (size_t)T * D) return;
    const float4 v = *(const float4*)(x + i); *(uint2*)(xb + i) = make_uint2(pk2(v.x, v.y), pk2(v.z, v.w));
}
template <int MODE>
__global__ __launch_bounds__(256) void gemm(const bf16* __restrict__ A, int lda, const int* __restrict__ list, const unsigned* __restrict__ cnt, int e, int Mmax,
                                            const float* __restrict__ B0, const float* __restrict__ B1, int ldb, bf16* C, int ldc, int K,
                                            const float* __restrict__ ssq, const float* __restrict__ ga, const float* __restrict__ gr, const bf16* __restrict__ res) {
    int M = Mmax, obase = 0;
    if (cnt) { M = (int)cnt[e]; for (int j = 0; j < e; ++j) obase += (((int)cnt[j] + 255) >> 8) << 8; }
    const int m0 = blockIdx.y * 64, n0 = blockIdx.x * 64;
    if (m0 >= M) return;
    __shared__ float As[16][65];
    __shared__ float Bs[16][64];
    __shared__ float Bs1[MODE == 1 ? 16 : 1][64];
    const int tid = threadIdx.x, tx = tid & 15, ty = tid >> 4;
    float acc[4][4] = {}, acc1[4][4] = {};
    const int ar = tid >> 2, ak = (tid & 3) * 4;
    const int arow = m0 + ar; const bool avalid = arow < M;
    const int srow = avalid ? (list ? list[(size_t)e * T + arow] : (cnt ? obase + arow : arow)) : 0;
    float sa = 1.f, sr = 1.f;
    if (MODE == 3) { float a = 0.f, r = 0.f; for (int j = 0; j < 8; ++j) { a += ssq[(size_t)srow * 16 + j]; r += ssq[(size_t)srow * 16 + 8 + j]; } sa = rsqrtf(a * (1.f / 512.f) + RMS_EPS); sr = rsqrtf(r * (1.f / 512.f) + RMS_EPS); }
    const int bk = tid >> 4, bn = (tid & 15) * 4;
    for (int k0 = 0; k0 < K; k0 += 16) {
        float av[4] = {0.f, 0.f, 0.f, 0.f};
        if (avalid) { const uint2 raw = *(const uint2*)(A + (size_t)srow * lda + k0 + ak);
            av[0] = bf2f((bf16)(raw.x & 0xffff)); av[1] = bf2f((bf16)(raw.x >> 16)); av[2] = bf2f((bf16)(raw.y & 0xffff)); av[3] = bf2f((bf16)(raw.y >> 16));
            if (MODE == 3) { for (int j = 0; j < 4; ++j) { const int k = k0 + ak + j; av[j] *= (k < 512) ? sa * ga[k] : sr * gr[k - 512]; } } }
        As[ak + 0][ar] = av[0]; As[ak + 1][ar] = av[1]; As[ak + 2][ar] = av[2]; As[ak + 3][ar] = av[3];
        *(float4*)&Bs[bk][bn] = *(const float4*)(B0 + (size_t)(k0 + bk) * ldb + n0 + bn);
        if (MODE == 1) *(float4*)&Bs1[bk][bn] = *(const float4*)(B1 + (size_t)(k0 + bk) * ldb + n0 + bn);
        __syncthreads();
#pragma unroll
        for (int k = 0; k < 16; ++k) {
            float a[4], b[4], b1[4];
#pragma unroll
            for (int j = 0; j < 4; ++j) { a[j] = As[k][ty * 4 + j]; b[j] = Bs[k][tx * 4 + j]; if (MODE == 1) b1[j] = Bs1[k][tx * 4 + j]; }
#pragma unroll
            for (int j = 0; j < 4; ++j)
#pragma unroll
                for (int l = 0; l < 4; ++l) { acc[j][l] += a[j] * b[l]; if (MODE == 1) acc1[j][l] += a[j] * b1[l]; }
        }
        __syncthreads();
    }
#pragma unroll
    for (int j = 0; j < 4; ++j) {
        const int r = m0 + ty * 4 + j; if (r >= M) continue;
        float o[4];
#pragma unroll
        for (int l = 0; l < 4; ++l) { o[l] = acc[j][l]; if (MODE == 1) { const float g = acc[j][l]; o[l] = g / (1.f + __expf(-g)) * acc1[j][l]; }
            if (MODE == 3) o[l] = ALPHA * bf2f(res[(size_t)r * ldc + n0 + tx * 4 + l]) + acc[j][l]; }
        *(uint2*)(C + (size_t)(obase + r) * ldc + n0 + tx * 4) = make_uint2(pk2(o[0], o[1]), pk2(o[2], o[3]));
    }
}
__global__ void rope_scale(bf16* proj) {
    const size_t i = (size_t)blockIdx.x * blockDim.x + threadIdx.x; if (i >= (size_t)T * 1024) return;
    const int c = (int)(i & 1023); const size_t t = i >> 10; const int d = c & 63, s = (int)(t % NS);
    bf16* p = proj + t * NPROJ + c; const float sc = c < 512 ? C2 : 1.f;
    if (d >= 16) { if (c < 512) *p = (bf16)f2bf(bf2f(*p) * sc); return; }
    if (d >= 8) return;
    const float inv = powf(500000.0f, -(float)d / 8.0f), ang = (float)s * inv, cs = cosf(ang), sn = sinf(ang);
    const float a = bf2f(p[0]), b = bf2f(p[8]);
    p[0] = (bf16)f2bf((a * cs - b * sn) * sc); p[8] = (bf16)f2bf((b * cs + a * sn) * sc);
}
__global__ void kmean(const bf16* __restrict__ proj, bf16* __restrict__ km) {
    const int i = blockIdx.x * blockDim.x + threadIdx.x; if (i >= NB * NH * NBLK * HD) return;
    const int d = i & 63, blk = (i >> 6) & 15, h = (i >> 10) & 7, b = i >> 13; float s = 0.f;
    for (int r = 0; r < 256; ++r) s += bf2f(proj[((size_t)b * NS + blk * 256 + r) * NPROJ + KOFF + h * 64 + d]);
    km[i] = (bf16)f2bf(s * (1.f / 256.f));
}
__global__ __launch_bounds__(64) void attn(const bf16* __restrict__ proj, const bf16* __restrict__ km, bf16* __restrict__ mix) {
    const int idx = blockIdx.x, h = idx & 7; const int t = idx >> 3, b = t / NS, s = t % NS, bi = s >> 8, lane = threadIdx.x;
    __shared__ float qs[64]; __shared__ float ps[1024]; __shared__ int sel[3]; __shared__ float gate[16];
    qs[lane] = bf2f(proj[(size_t)t * NPROJ + h * 64 + lane]);
    __syncthreads();
    if (lane < 16) { float g = -INFINITY;
        if (lane < bi) { g = 0.f; const bf16* kp = km + ((b * NH + h) * NBLK + lane) * 64; for (int d = 0; d < 64; ++d) g += qs[d] * bf2f(kp[d]); }
        gate[lane] = g; }
    __syncthreads();
    if (lane == 0) { unsigned used = 0u;
        for (int r = 0; r < 3; ++r) { int best = -1; float bv = -INFINITY;
            for (int j = 0; j < 16; ++j) if (!((used >> j) & 1u) && (best < 0 || gate[j] > bv)) { best = j; bv = gate[j]; }
            used |= 1u << best; sel[r] = best; } }
    __syncthreads();
    const int nblk = bi < 3 ? bi : 3; float mx = -INFINITY;
    for (int j = 0; j < 4; ++j) { const int blk = (j < 3) ? sel[j] : bi; const bool valid = (j < 3) ? (j < nblk) : true;
        for (int i = 0; i < 4; ++i) { const int key = blk * 256 + i * 64 + lane; float sc = -INFINITY;
            if (valid && !(j == 3 && key > s)) { const bf16* kp = proj + ((size_t)b * NS + key) * NPROJ + KOFF + h * 64; float a = 0.f; for (int d = 0; d < 64; ++d) a += qs[d] * bf2f(kp[d]); sc = a; }
            ps[j * 256 + i * 64 + lane] = sc; mx = fmaxf(mx, sc); } }
    mx = wmax(mx); float sum = 0.f;
    for (int e2 = lane; e2 < 1024; e2 += 64) { const float p = (ps[e2] == -INFINITY) ? 0.f : exp2f(ps[e2] - mx); ps[e2] = p; sum += p; }
    sum = wsum(sum);
    __syncthreads();
    const float inv = 1.f / sum; float acc = 0.f;
    for (int j = 0; j < 4; ++j) { const int blk = (j < 3) ? sel[j] : bi; const bool valid = (j < 3) ? (j < nblk) : true; if (!valid) continue;
        for (int i = 0; i < 256; ++i) { const float p = ps[j * 256 + i]; if (p != 0.f) acc += p * bf2f(proj[((size_t)b * NS + blk * 256 + i) * NPROJ + VOFF + h * 64 + lane]); } }
    mix[(size_t)t * D + h * 64 + lane] = (bf16)f2bf(acc * inv);
}
__global__ __launch_bounds__(64) void rglru_gates(const bf16* __restrict__ proj, const float* __restrict__ conv_w, const float* __restrict__ conv_b,
                                                  const float* __restrict__ w_a, const float* __restrict__ b_a, const float* __restrict__ w_i, const float* __restrict__ b_i,
                                                  const float* __restrict__ lam, float* __restrict__ Aout, float* __restrict__ Uout) {
    const int n = blockIdx.x & 7; const size_t t = blockIdx.x >> 3; const int c = threadIdx.x, ch = n * 64 + c, s = (int)(t % NS);
    float xc = conv_b[ch];
    for (int w = 0; w < 4; ++w) { const int sp = s - 3 + w; if (sp >= 0) xc += conv_w[w * 512 + ch] * bf2f(proj[(t - 3 + w) * NPROJ + XROFF + ch]); }
    __shared__ float xs[64]; xs[c] = xc; __syncthreads();
    float ra = b_a[ch], ri = b_i[ch];
    for (int cc = 0; cc < 64; ++cc) { ra += xs[cc] * w_a[(n * 64 + cc) * 64 + c]; ri += xs[cc] * w_i[(n * 64 + cc) * 64 + c]; }
    const float r = 1.f / (1.f + expf(-ra)), ig = 1.f / (1.f + expf(-ri));
    const float la = -8.0f * r * log1pf(expf(-lam[ch]));
    Aout[t * 512 + ch] = expf(la); Uout[t * 512 + ch] = sqrtf(-expm1f(2.f * la)) * (ig * xc);
}
__global__ void rglru_scan(const float* __restrict__ Aa, const float* __restrict__ U, const bf16* __restrict__ proj, bf16* __restrict__ mix) {
    const int i = blockIdx.x * blockDim.x + threadIdx.x; if (i >= NB * 512) return;
    const int b = i >> 9, ch = i & 511; float h = 0.f;
    for (int s0 = 0; s0 < NS; s0 += 8) {
        float a[8], u[8], g[8];
#pragma unroll
        for (int j = 0; j < 8; ++j) { const size_t t = (size_t)b * NS + s0 + j; a[j] = Aa[t * 512 + ch]; u[j] = U[t * 512 + ch]; g[j] = bf2f(proj[t * NPROJ + GROFF + ch]); }
#pragma unroll
        for (int j = 0; j < 8; ++j) { const size_t t = (size_t)b * NS + s0 + j; h = a[j] * h + u[j]; mix[t * D + 512 + ch] = (bf16)f2bf(h * gelu_tanh_f(g[j])); }
    }
}
__global__ void ssq_groups(const bf16* __restrict__ mix, float* __restrict__ ssq) {
    const size_t i = (size_t)blockIdx.x * blockDim.x + threadIdx.x; if (i >= (size_t)T * 16) return;
    const bf16* p = mix + (i >> 4) * D + (i & 15) * 64; float s = 0.f; for (int j = 0; j < 64; ++j) { const float v = bf2f(p[j]); s += v * v; } ssq[i] = s;
}
__global__ __launch_bounds__(256) void ln_router(const bf16* __restrict__ pre, const float* __restrict__ g, const float* __restrict__ bb, bf16* __restrict__ x1,
                                                 const float* __restrict__ wg, const float* __restrict__ bg, const float* __restrict__ we, const float* __restrict__ be,
                                                 unsigned* cnt, int* list, uint4* tokinfo) {
    const int t = blockIdx.x * 4 + (threadIdx.x >> 6), lane = threadIdx.x & 63;
    float v[16], s = 0.f;
#pragma unroll
    for (int j = 0; j < 16; ++j) { v[j] = bf2f(pre[(size_t)t * D + j * 64 + lane]); s += v[j]; }
    const float mu = wsum(s) * (1.f / 1024.f); float q = 0.f;
#pragma unroll
    for (int j = 0; j < 16; ++j) { v[j] -= mu; q += v[j] * v[j]; }
    const float rstd = rsqrtf(wsum(q) * (1.f / 1024.f) + LN_EPS);
    float lg[4] = {}, le[16] = {};
#pragma unroll
    for (int j = 0; j < 16; ++j) { const int c = j * 64 + lane; const float xv = v[j] * rstd * g[c] + bb[c]; x1[(size_t)t * D + c] = (bf16)f2bf(xv);
#pragma unroll
        for (int o = 0; o < 4; ++o) lg[o] += xv * wg[c * 4 + o];
#pragma unroll
        for (int o = 0; o < 16; ++o) le[o] += xv * we[c * 16 + o]; }
#pragma unroll
    for (int o = 0; o < 4; ++o) lg[o] = wsum(lg[o]) + bg[o];
#pragma unroll
    for (int o = 0; o < 16; ++o) le[o] = wsum(le[o]) + be[o];
    int gi = 0; float gv = lg[0];
#pragma unroll
    for (int o = 1; o < 4; ++o) if (lg[o] > gv) { gi = o; gv = lg[o]; }
    float gs = 0.f;
#pragma unroll
    for (int o = 0; o < 4; ++o) gs += expf(lg[o] - gv);
    const float gp = 1.f / gs; float l4[4];
#pragma unroll
    for (int o = 0; o < 4; ++o) l4[o] = gi == 0 ? le[o] : gi == 1 ? le[4 + o] : gi == 2 ? le[8 + o] : le[12 + o];
    int e0 = 0; float v0 = l4[0];
#pragma unroll
    for (int o = 1; o < 4; ++o) if (l4[o] > v0) { e0 = o; v0 = l4[o]; }
    int e1 = -1; float v1 = -INFINITY;
#pragma unroll
    for (int o = 0; o < 4; ++o) if (o != e0 && (e1 < 0 || l4[o] > v1)) { e1 = o; v1 = l4[o]; }
    const float p1 = expf(v1 - v0), w0 = gp / (1.f + p1), w1 = gp * p1 / (1.f + p1);
    if (lane == 0) { const int E0 = gi * 4 + e0, E1 = gi * 4 + e1;
        const unsigned p0 = atomicAdd(&cnt[E0], 1u); list[(size_t)E0 * T + p0] = t;
        const unsigned p1_ = atomicAdd(&cnt[E1], 1u); list[(size_t)E1 * T + p1_] = t;
        tokinfo[t] = make_uint4(((unsigned)E0 << 24) | p0, ((unsigned)E1 << 24) | p1_, __float_as_uint(w0), __float_as_uint(w1)); }
}
__global__ __launch_bounds__(256) void combine_ln(const bf16* __restrict__ x1, const bf16* __restrict__ Y, const uint4* __restrict__ tokinfo, const unsigned* __restrict__ cnt,
                                                  const float* __restrict__ g, const float* __restrict__ bb, bf16* xb, float* outf) {
    const int t = blockIdx.x * 4 + (threadIdx.x >> 6), lane = threadIdx.x & 63;
    const uint4 ti = tokinfo[t]; const int E0 = ti.x >> 24, E1 = ti.y >> 24; int b0 = 0, b1 = 0;
    for (int j = 0; j < 16; ++j) { const int pc = (((int)cnt[j] + 255) >> 8) << 8; if (j < E0) b0 += pc; if (j < E1) b1 += pc; }
    const size_t s0 = (size_t)b0 + (ti.x & 0xffffff), s1 = (size_t)b1 + (ti.y & 0xffffff); const float w0 = __uint_as_float(ti.z), w1 = __uint_as_float(ti.w);
    float v[16], s = 0.f;
#pragma unroll
    for (int j = 0; j < 16; ++j) { const int c = j * 64 + lane; v[j] = ALPHA * bf2f(x1[(size_t)t * D + c]) + w0 * bf2f(Y[s0 * D + c]) + w1 * bf2f(Y[s1 * D + c]); s += v[j]; }
    const float mu = wsum(s) * (1.f / 1024.f); float q = 0.f;
#pragma unroll
    for (int j = 0; j < 16; ++j) { v[j] -= mu; q += v[j] * v[j]; }
    const float rstd = rsqrtf(wsum(q) * (1.f / 1024.f) + LN_EPS);
#pragma unroll
    for (int j = 0; j < 16; ++j) { const int c = j * 64 + lane; const float o = v[j] * rstd * g[c] + bb[c]; if (outf) outf[(size_t)t * D + c] = o; else xb[(size_t)t * D + c] = (bf16)f2bf(o); }
}
}
namespace mk {
using namespace cfg;
#define LAS __attribute__((address_space(3)))
#define GAS __attribute__((address_space(1)))
typedef short bf16x8 __attribute__((ext_vector_type(8)));
typedef short s16x4 __attribute__((ext_vector_type(4)));
typedef float f32x4 __attribute__((ext_vector_type(4)));
typedef float f32x2 __attribute__((ext_vector_type(2)));
typedef float f32x16 __attribute__((ext_vector_type(16)));
typedef unsigned u32x4 __attribute__((ext_vector_type(4)));
typedef unsigned u32x2 __attribute__((ext_vector_type(2)));
typedef GAS unsigned gu32;

constexpr int BM = 256, BK = 64, HALF = 128, HTB = HALF * BK * 2, STAGE_BYTES = 8 * HTB, NXCD = 8, WGM = 8;
constexpr int RING_OFF = 0, RING_BYTES = 131072;
constexpr int TAB_OFF = RING_BYTES;
constexpr int TAB_RS = TAB_OFF;
constexpr int TAB_GIDX = TAB_OFF + 4096;
constexpr int TAB_TB = TAB_OFF + 10240;
constexpr int TAB_BYTES = 20480;
constexpr int LDSCTL_OFF = TAB_OFF + TAB_BYTES, MISC_OFF = LDSCTL_OFF + 320;
constexpr int LDS_BYTES = 155648;
static_assert(MISC_OFF + 128 <= LDS_BYTES, "LDS map");

__host__ __device__ __forceinline__ int lds_byte(int r, int c) { const int st = (r >> 4) * 2 + (c >> 5), rr = r & 15, cc = c & 31, ob = rr * 64 + cc * 2; return st * 1024 + (ob ^ (((ob >> 9) & 1) << 5)); }
__host__ __device__ __forceinline__ void stage_rc(int b, int& R, int& C) { const int st = b / 1024, sb = b % 1024, swz = sb ^ (((sb >> 9) & 1) << 5); R = (st >> 1) * 16 + swz / 64; C = (st & 1) * 32 + (swz % 64) / 2; }
__host__ __device__ __forceinline__ int perm32(int rho) { const int n = rho >> 4, i = rho & 15; return 8 * (i >> 2) + 4 * n + (i & 3); }
__device__ __forceinline__ unsigned cvt_pk_bf16(float lo, float hi) { unsigned r; asm volatile("v_cvt_pk_bf16_f32 %0, %1, %2" : "=v"(r) : "v"(lo), "v"(hi)); return r; }

struct Unit { const char* A; const char* B; int orow, ocol, slot; };

struct TileOrder {
    int nM, nN, nwg, G, c;
    __device__ void init(int nM_, int nN_, int G_, int c_) { nM = nM_; nN = nN_; nwg = nM * nN; G = G_; c = c_; }
    __device__ bool tile(int i, int& pm, int& pn) const {
        const long L = (long)i * G + c; if (L >= nwg) return false;
        int wgid = (int)L; { const int q = nwg / NXCD, r = nwg % NXCD, xcd = wgid % NXCD, off = wgid / NXCD; wgid = (xcd < r ? xcd * (q + 1) : r * (q + 1) + (xcd - r) * q) + off; }
        const int nig = WGM * nN, gid = wgid / nig, fm = gid * WGM, gsz = (nM - fm) < WGM ? (nM - fm) : WGM;
        pm = fm + ((wgid % nig) % gsz); pn = (wgid % nig) / gsz; return true;
    }
};

template <class Epi, class Sched, bool GATHER, bool MIDK>
__device__ __forceinline__ void gemm_phase(LAS unsigned char* lds, const int K, const Sched& S, const Epi& E, const LAS unsigned* gidx) {
    int tid_ = threadIdx.x; asm volatile("" : "+v"(tid_));
    const int tid = tid_, wid = __builtin_amdgcn_readfirstlane(tid >> 6), lane = tid & 63, wr = wid >> 2, wc = wid & 3, fr = lane & 15, fq = lane >> 4;
    const int nt = K / BK;
    unsigned voffB[2], voffC[2][2], voffN[2][2]; int gR[2], gC[2];
#pragma unroll
    for (int i = 0; i < 2; ++i) { int R, C; stage_rc(tid * 16 + i * 8192, R, C); const int Rb = (R & ~31) + perm32(R & 31);
        voffB[i] = (unsigned)(Rb * K + C) * 2u; gR[i] = R; gC[i] = C * 2;
        voffC[0][i] = (unsigned)(R * K + C) * 2u; voffC[1][i] = (unsigned)((R + HALF) * K + C) * 2u; voffN[0][i] = voffC[0][i]; voffN[1][i] = voffC[1][i]; }
    const size_t kstep = (size_t)(BK * 2);
    const size_t hstep = (size_t)HALF * K * 2;
    const unsigned ldsw = (unsigned)wid * 1024u;
    const int aoff = lds_byte(wr * 64 + fr, fq * 8), boff = lds_byte(wc * 32 + fr, fq * 8);
#define PG8_SA(b, h) (((b) * 2 + (h)) * HTB)
#define PG8_SB(b, h) ((4 + (b) * 2 + (h)) * HTB)
#define PG8_STB(bufoff, gbase) do { _Pragma("unroll") for (int _i = 0; _i < 2; ++_i) \
        __builtin_amdgcn_global_load_lds((const unsigned*)((const char*)(gbase) + voffB[_i]), (LAS unsigned*)(lds + (bufoff) + ldsw + _i * 8192), 16, 0, 0); } while (0)
#define PG8_STA(bufoff, gbase, VO, h) do { _Pragma("unroll") for (int _i = 0; _i < 2; ++_i) \
        __builtin_amdgcn_global_load_lds((const unsigned*)((const char*)(gbase) + (VO)[h][_i]), (LAS unsigned*)(lds + (bufoff) + ldsw + _i * 8192), 16, 0, 0); } while (0)
#define PG8_LDA(dst, b, h) do { _Pragma("unroll") for (int m = 0; m < 4; ++m) _Pragma("unroll") for (int k = 0; k < 2; ++k) dst[m][k] = *(const LAS bf16x8*)(lds + PG8_SA(b, h) + aoff + m * 2048 + k * 1024); } while (0)
#define PG8_LDB(dst, b, h) do { _Pragma("unroll") for (int n = 0; n < 2; ++n) _Pragma("unroll") for (int k = 0; k < 2; ++k) dst[n][k] = *(const LAS bf16x8*)(lds + PG8_SB(b, h) + boff + n * 2048 + k * 1024); } while (0)
#define PG8_MMA(ai, bj, At, Bt) do { __builtin_amdgcn_s_setprio(1); _Pragma("unroll") for (int m = 0; m < 4; ++m) _Pragma("unroll") for (int n = 0; n < 2; ++n) _Pragma("unroll") for (int k = 0; k < 2; ++k) \
        acc[ai][bj][m][n] = __builtin_amdgcn_mfma_f32_16x16x32_bf16(Bt[n][k], At[m][k], acc[ai][bj][m][n], 0, 0, 0); __builtin_amdgcn_s_setprio(0); } while (0)
#define PG8_WAIT_V(n) asm volatile("s_waitcnt vmcnt(" #n ")" ::: "memory")
#define PG8_WAIT_L(n) asm volatile("s_waitcnt lgkmcnt(" #n ")" ::: "memory")
#define PG8_BAR __builtin_amdgcn_s_barrier()
#define PG8_SCHED __builtin_amdgcn_sched_barrier(0)
#define PG8_GLOAD(VO, slot_) do { if constexpr (GATHER) { _Pragma("unroll") for (int _h = 0; _h < 2; ++_h) _Pragma("unroll") for (int _i = 0; _i < 2; ++_i) \
        (VO)[_h][_i] = gidx[(slot_) * 256 + _h * HALF + gR[_i]] * (unsigned)(K * 2) + (unsigned)gC[_i]; } } while (0)
    Unit cur, nxt; int ui = 0;
    if (!S.next(0, cur)) return;
    f32x4 acc[2][2][4][2];
#pragma unroll
    for (int a = 0; a < 2; ++a)
#pragma unroll
        for (int b = 0; b < 2; ++b)
#pragma unroll
            for (int m = 0; m < 4; ++m)
#pragma unroll
                for (int n = 0; n < 2; ++n) acc[a][b][m][n] = (f32x4){0.f, 0.f, 0.f, 0.f};
    bf16x8 At[4][2], B0[2][2], B1[2][2];
    const char* cA = cur.A; const char* cB = cur.B;
    PG8_GLOAD(voffC, cur.slot);
    E.prep(cur, 0, tid);
    PG8_STB(PG8_SB(0, 0), cB); PG8_STB(PG8_SB(0, 1), cB + hstep); PG8_STA(PG8_SA(0, 0), cA, voffC, 0); PG8_STA(PG8_SA(0, 1), cA, voffC, 1);
    if (wr == 1) PG8_BAR;
    PG8_WAIT_V(2); PG8_BAR;
    PG8_STB(PG8_SB(1, 0), cB + kstep); PG8_STA(PG8_SA(1, 0), cA + kstep, voffC, 0); PG8_STB(PG8_SB(1, 1), cB + hstep + kstep);
    PG8_WAIT_V(6); PG8_BAR;
    for (;;) {
        const bool has_next = S.next(ui + 1, nxt);
        const char* nA = has_next ? nxt.A : cA; const char* nB = has_next ? nxt.B : cB;
        if constexpr (GATHER) { if (has_next) PG8_GLOAD(voffN, nxt.slot); else { _Pragma("unroll") for (int _h = 0; _h < 2; ++_h) _Pragma("unroll") for (int _i = 0; _i < 2; ++_i) voffN[_h][_i] = voffC[_h][_i]; } }
        for (int t = 0; t < nt; t += 2) {
            const bool last = (t == nt - 2);
            const char* a1 = cA + (size_t)(t + 1) * kstep;
            const char* a2 = last ? nA : cA + (size_t)(t + 2) * kstep; const char* b2 = last ? nB : cB + (size_t)(t + 2) * kstep;
            const char* a3 = a2 + kstep; const char* b3 = b2 + kstep;
            unsigned vo2[2][2];
#pragma unroll
            for (int _h = 0; _h < 2; ++_h)
#pragma unroll
                for (int _i = 0; _i < 2; ++_i) vo2[_h][_i] = (GATHER && last) ? voffN[_h][_i] : voffC[_h][_i];
            if (last && has_next) E.prep(nxt, ui + 1, tid);
            PG8_LDB(B0, 0, 0); PG8_LDB(B1, 0, 1); PG8_SCHED; PG8_LDA(At, 0, 0); PG8_STA(PG8_SA(1, 1), a1, voffC, 1);
            PG8_WAIT_V(8); PG8_WAIT_L(0); PG8_BAR; PG8_MMA(0, 0, At, B0); PG8_MMA(0, 1, At, B1); PG8_BAR; PG8_SCHED;
            PG8_LDA(At, 0, 1); PG8_STB(PG8_SB(0, 0), b2); PG8_STB(PG8_SB(0, 1), b2 + hstep); PG8_STA(PG8_SA(0, 0), a2, vo2, 0);
            PG8_WAIT_V(8); PG8_WAIT_L(0); PG8_BAR; PG8_MMA(1, 0, At, B0); PG8_MMA(1, 1, At, B1); PG8_BAR; PG8_SCHED;
            PG8_LDB(B0, 1, 0); PG8_LDB(B1, 1, 1); PG8_SCHED; PG8_LDA(At, 1, 0); PG8_STA(PG8_SA(0, 1), a2, vo2, 1);
            PG8_WAIT_V(8); PG8_WAIT_L(0); PG8_BAR; PG8_MMA(0, 0, At, B0); PG8_MMA(0, 1, At, B1); PG8_BAR; PG8_SCHED;
            PG8_LDA(At, 1, 1); PG8_STB(PG8_SB(1, 0), b3); PG8_STB(PG8_SB(1, 1), b3 + hstep); PG8_STA(PG8_SA(1, 0), a3, vo2, 0);
            PG8_WAIT_V(8); PG8_WAIT_L(0); PG8_BAR; PG8_MMA(1, 0, At, B0); PG8_MMA(1, 1, At, B1); PG8_BAR; PG8_SCHED;
            if constexpr (MIDK) { if (t + 2 == (nt >> 1)) E.midk(acc, ui, wr, fr); }
        }
        if (wr == 0) PG8_BAR;
        E(acc, cur, ui, wr, wc, fr, fq);
        if (!has_next) break;
#pragma unroll
        for (int a = 0; a < 2; ++a)
#pragma unroll
            for (int b = 0; b < 2; ++b)
#pragma unroll
                for (int m = 0; m < 4; ++m)
#pragma unroll
                    for (int n = 0; n < 2; ++n) acc[a][b][m][n] = (f32x4){0.f, 0.f, 0.f, 0.f};
        cur = nxt; cA = nA; cB = nB; ++ui;
#pragma unroll
        for (int _h = 0; _h < 2; ++_h)
#pragma unroll
            for (int _i = 0; _i < 2; ++_i) voffC[_h][_i] = voffN[_h][_i];
        if (wr == 1) PG8_BAR;
    }
    PG8_WAIT_V(0);
    PG8_BAR;
#undef PG8_SA
#undef PG8_SB
#undef PG8_STB
#undef PG8_STA
#undef PG8_LDA
#undef PG8_LDB
#undef PG8_MMA
#undef PG8_WAIT_V
#undef PG8_WAIT_L
#undef PG8_BAR
#undef PG8_SCHED
#undef PG8_GLOAD
}
struct EpiProj {
    bf16* O; const float2* rope;
    __device__ __forceinline__ void prep(const Unit&, int, int) const {}
    __device__ __forceinline__ void operator()(const f32x4 (&acc)[2][2][4][2], const Unit& u, int, int wr, int wc, int fr, int fq) const {
        const int row0 = u.orow + wr * 64 + fr, col0 = u.ocol + wc * 32 + 8 * fq;
        const bool isq = u.ocol < 512, dorope = (u.ocol < 1024) && ((wc & 1) == 0);
        const float sc = isq ? C2 : 1.f;
#pragma unroll
        for (int ai = 0; ai < 2; ++ai)
#pragma unroll
            for (int m = 0; m < 4; ++m) { const int row = row0 + ai * HALF + m * 16; bf16* rowp = O + (size_t)row * NPROJ + col0;
                float cs[8], sn[8];
                if (dorope) { const f32x4* rp = (const f32x4*)(rope + (size_t)(row & (NS - 1)) * 8);
#pragma unroll
                    for (int j = 0; j < 4; ++j) { const f32x4 t = rp[j]; cs[2 * j] = t[0]; sn[2 * j] = t[1]; cs[2 * j + 1] = t[2]; sn[2 * j + 1] = t[3]; } }
#pragma unroll
                for (int bj = 0; bj < 2; ++bj) { float v[8];
#pragma unroll
                    for (int j = 0; j < 4; ++j) { v[j] = acc[ai][bj][m][0][j]; v[4 + j] = acc[ai][bj][m][1][j]; }
                    if (dorope) {
#pragma unroll
                        for (int j = 0; j < 8; ++j) { const float p = __shfl_xor(v[j], 16); const float r0 = v[j] * cs[j] - p * sn[j], r1 = v[j] * cs[j] + p * sn[j]; v[j] = fq == 0 ? r0 : (fq == 1 ? r1 : v[j]); } }
                    u32x4 w; w.x = cvt_pk_bf16(v[0] * sc, v[1] * sc); w.y = cvt_pk_bf16(v[2] * sc, v[3] * sc); w.z = cvt_pk_bf16(v[4] * sc, v[5] * sc); w.w = cvt_pk_bf16(v[6] * sc, v[7] * sc);
                    *(u32x4*)(rowp + bj * HALF) = w; } }
    }
};
struct EpiOut {
    bf16* PRE; const bf16* XB; const float* SSQ; LAS f32x2* RS;
    __device__ __forceinline__ void prep(const Unit& u, int ui, int tid) const {
        if (tid < 256) { const f32x4* p = (const f32x4*)(SSQ + (size_t)(u.orow + tid) * 16); const f32x4 a0 = p[0], a1 = p[1], r0 = p[2], r1 = p[3];
            const float sa = ((a0[0] + a0[1]) + (a0[2] + a0[3])) + ((a1[0] + a1[1]) + (a1[2] + a1[3])), sr = ((r0[0] + r0[1]) + (r0[2] + r0[3])) + ((r1[0] + r1[1]) + (r1[2] + r1[3]));
            const float ia = rsqrtf(sa * (1.f / 512.f) + RMS_EPS), ir = rsqrtf(sr * (1.f / 512.f) + RMS_EPS);
            RS[(ui & 1) * 256 + tid] = (f32x2){ia / ir, ir}; }
    }
    __device__ __forceinline__ void midk(f32x4 (&acc)[2][2][4][2], int ui, int wr, int fr) const {
#pragma unroll
        for (int ai = 0; ai < 2; ++ai)
#pragma unroll
            for (int m = 0; m < 4; ++m) { const float ra = RS[(ui & 1) * 256 + ai * HALF + wr * 64 + m * 16 + fr].x;
#pragma unroll
                for (int bj = 0; bj < 2; ++bj)
#pragma unroll
                    for (int n = 0; n < 2; ++n) acc[ai][bj][m][n] = acc[ai][bj][m][n] * ra; }
    }
    __device__ __forceinline__ void operator()(const f32x4 (&acc)[2][2][4][2], const Unit& u, int ui, int wr, int wc, int fr, int fq) const {
        const int col0 = u.ocol + wc * 32 + 8 * fq;
#pragma unroll
        for (int ai = 0; ai < 2; ++ai)
#pragma unroll
            for (int m = 0; m < 4; ++m) { const int rl = ai * HALF + wr * 64 + m * 16 + fr; const float sr = RS[(ui & 1) * 256 + rl].y; const size_t off = (size_t)(u.orow + rl) * D + col0;
#pragma unroll
                for (int bj = 0; bj < 2; ++bj) { const u32x4 xr = *(const u32x4*)(XB + off + bj * HALF); float v[8];
#pragma unroll
                    for (int j = 0; j < 4; ++j) { v[j] = acc[ai][bj][m][0][j] * sr; v[4 + j] = acc[ai][bj][m][1][j] * sr; }
#pragma unroll
                    for (int j = 0; j < 4; ++j) { v[2 * j] += ALPHA * __uint_as_float(xr[j] << 16); v[2 * j + 1] += ALPHA * __uint_as_float(xr[j] & 0xffff0000u); }
                    u32x4 w; w.x = cvt_pk_bf16(v[0], v[1]); w.y = cvt_pk_bf16(v[2], v[3]); w.z = cvt_pk_bf16(v[4], v[5]); w.w = cvt_pk_bf16(v[6], v[7]);
                    *(u32x4*)(PRE + off + bj * HALF) = w; } }
    }
};
struct EpiSwiglu {
    bf16* H;
    __device__ __forceinline__ void prep(const Unit&, int, int) const {}
    __device__ __forceinline__ void operator()(const f32x4 (&acc)[2][2][4][2], const Unit& u, int, int wr, int wc, int fr, int fq) const {
        const int col0 = u.ocol + wc * 32 + 8 * fq;
#pragma unroll
        for (int ai = 0; ai < 2; ++ai)
#pragma unroll
            for (int m = 0; m < 4; ++m) { float v[8];
#pragma unroll
                for (int n = 0; n < 2; ++n)
#pragma unroll
                    for (int j = 0; j < 4; ++j) { const float g = acc[ai][0][m][n][j], up = acc[ai][1][m][n][j]; v[4 * n + j] = g * __builtin_amdgcn_rcpf(1.f + __expf(-g)) * up; }
                u32x4 w; w.x = cvt_pk_bf16(v[0], v[1]); w.y = cvt_pk_bf16(v[2], v[3]); w.z = cvt_pk_bf16(v[4], v[5]); w.w = cvt_pk_bf16(v[6], v[7]);
                *(u32x4*)(H + (size_t)(u.orow + ai * HALF + wr * 64 + m * 16 + fr) * DEXP + col0) = w; }
    }
};
struct EpiPlain {
    bf16* O; int ldc;
    __device__ __forceinline__ void prep(const Unit&, int, int) const {}
    __device__ __forceinline__ void operator()(const f32x4 (&acc)[2][2][4][2], const Unit& u, int, int wr, int wc, int fr, int fq) const {
        const int col0 = u.ocol + wc * 32 + 8 * fq;
#pragma unroll
        for (int ai = 0; ai < 2; ++ai)
#pragma unroll
            for (int m = 0; m < 4; ++m) { bf16* rowp = O + (size_t)(u.orow + ai * HALF + wr * 64 + m * 16 + fr) * ldc + col0;
#pragma unroll
                for (int bj = 0; bj < 2; ++bj) { const f32x4 v0 = acc[ai][bj][m][0], v1 = acc[ai][bj][m][1];
                    u32x4 w; w.x = cvt_pk_bf16(v0[0], v0[1]); w.y = cvt_pk_bf16(v0[2], v0[3]); w.z = cvt_pk_bf16(v1[0], v1[1]); w.w = cvt_pk_bf16(v1[2], v1[3]);
                    *(u32x4*)(rowp + bj * HALF) = w; } }
    }
};
struct DenseOrder {
    TileOrder to; const char* A; const char* B; size_t tstep;
    __device__ void init(const bf16* A_, const bf16* B_, int M, int N, int K, int G, int c) { to.init(M / BM, N / BM, G, c); A = (const char*)A_; B = (const char*)B_; tstep = (size_t)BM * K * 2; }
    __device__ __forceinline__ bool next(int i, Unit& u) const { int pm, pn; if (!to.tile(i, pm, pn)) return false; u.A = A + (size_t)pm * tstep; u.B = B + (size_t)pn * tstep; u.orow = pm * BM; u.ocol = pn * BM; u.slot = 0; return true; }
};
struct MoeOrder {
    const LAS unsigned* TB; int G, c; const char* A; const char* W; size_t a_tile, w_exp, w_tile; int ocol_step; bool gather;
    __device__ __forceinline__ bool next(int i, Unit& u) const {
        const int L = i * G + c; const int MT = (int)TB[16]; if (L >= 4 * MT) return false;
        const int mtg = L >> 2, pn = L & 3; int e = 0;
#pragma unroll
        for (int j = 1; j < 16; ++j) e += ((int)TB[j] <= mtg) ? 1 : 0;
        u.A = gather ? A : A + (size_t)mtg * a_tile; u.B = W + (size_t)e * w_exp + (size_t)pn * w_tile; u.orow = mtg * BM; u.ocol = pn * ocol_step; u.slot = i; return true;
    }
};
}
namespace attn_body {
using bf16=unsigned short;
using bf16x8=__attribute__((ext_vector_type(8)))short;
using s16x4=__attribute__((ext_vector_type(4)))short;
using f32x16=__attribute__((ext_vector_type(16)))float;
using u32x4=__attribute__((ext_vector_type(4)))unsigned;
constexpr int BATCH=8,NHEAD=8,SEQ=4096,D=64,PQ=2560,PO=1024;
constexpr int NW=8,QBLK=32,QB=QBLK*NW,KVBLK=64,NQB=SEQ/QB;
constexpr int ATTN_UNIT_ROWS=QB;
__device__ __forceinline__ int crow(int r,int hi){return (r&3)+8*(r>>2)+4*hi;}
#define SBAR() __builtin_amdgcn_sched_barrier(0)
__device__ __forceinline__ void cmask(f32x16&p0,f32x16&p1,int jb,int qrel,int hi){
  const float NEG=-INFINITY; int kb=64*jb+4*hi;
  #pragma unroll
  for(int r=0;r<16;++r){int kv=kb+(r&3)+8*(r>>2); if(kv>qrel)p0[r]=NEG; if(kv+32>qrel)p1[r]=NEG;}
}

constexpr int NSLOT=3, SLOTB=8192;
constexpr int LDS_K=0, LDS_V=NSLOT*SLOTB, LDS_WS=2*NSLOT*SLOTB, LDS_OST=LDS_WS+NW*64*4, LDS_BYTES=LDS_OST+NW*4096;
constexpr float C2=0.125f*1.4426950408889634f;
__device__ __forceinline__ void glds16(const void*gsrc,unsigned lds_dst){unsigned keep;
  asm volatile("s_mov_b32 %0, m0\n\ts_mov_b32 m0, %2\n\ts_nop 0\n\tglobal_load_lds_dwordx4 %1, off\n\ts_mov_b32 m0, %0":"=&s"(keep):"v"(gsrc),"s"(lds_dst):"memory");}
__device__ __forceinline__ float max3f(float a,float b,float c){float r;asm("v_max3_f32 %0, %1, %2, %3":"=v"(r):"v"(a),"v"(b),"v"(c));return r;}
__device__ __forceinline__ float max2f(float a,float b){float r;asm("v_max_f32_e32 %0, %1, %2":"=v"(r):"v"(a),"v"(b));return r;}
__device__ __forceinline__ float fadd_s(float a,float b){float r;asm("v_add_f32_e32 %0, %1, %2":"=v"(r):"v"(a),"v"(b));return r;}
__device__ __forceinline__ float fsub_s(float a,float b){float r;asm("v_sub_f32_e32 %0, %1, %2":"=v"(r):"v"(a),"v"(b));return r;}
typedef float f32x2_t __attribute__((ext_vector_type(2))); typedef __bf16 bf16x2_t __attribute__((ext_vector_type(2)));
__device__ __forceinline__ unsigned cvtpk_s(float lo,float hi){f32x2_t v={lo,hi};bf16x2_t b=__builtin_convertvector(v,bf16x2_t);return __builtin_bit_cast(unsigned,b);}
#define WAIT_BAR(N) asm volatile("s_waitcnt vmcnt(" #N ") lgkmcnt(0)\n\ts_barrier":::"memory")

__device__ __forceinline__ void qkt(f32x16&p0,f32x16&p1,const char*Kslot,const bf16x8*qr,const f32x16&negm,int r32,int hi){
  const char*kb=Kslot+hi*1024+r32*16;
  #pragma unroll
  for(int d0=0;d0<4;++d0){
    const bf16x8 b0=*reinterpret_cast<const bf16x8*>(kb+d0*2048);
    const bf16x8 b1=*reinterpret_cast<const bf16x8*>(kb+d0*2048+512);
    if(d0==0){p0=__builtin_amdgcn_mfma_f32_32x32x16_bf16(b0,qr[0],negm,0,0,0);p1=__builtin_amdgcn_mfma_f32_32x32x16_bf16(b1,qr[0],negm,0,0,0);}
    else{p0=__builtin_amdgcn_mfma_f32_32x32x16_bf16(b0,qr[d0],p0,0,0,0);p1=__builtin_amdgcn_mfma_f32_32x32x16_bf16(b1,qr[d0],p1,0,0,0);}}
}
typedef __attribute__((address_space(3))) const char* lds_cptr;
typedef short v4i16_t __attribute__((ext_vector_type(4)));
__device__ __forceinline__ void kload8(bf16x8*kf,lds_cptr kp){
  kf[0]=*(const __attribute__((address_space(3))) bf16x8*)(kp);      kf[1]=*(const __attribute__((address_space(3))) bf16x8*)(kp+512);
  kf[2]=*(const __attribute__((address_space(3))) bf16x8*)(kp+2048); kf[3]=*(const __attribute__((address_space(3))) bf16x8*)(kp+2560);
  kf[4]=*(const __attribute__((address_space(3))) bf16x8*)(kp+4096); kf[5]=*(const __attribute__((address_space(3))) bf16x8*)(kp+4608);
  kf[6]=*(const __attribute__((address_space(3))) bf16x8*)(kp+6144); kf[7]=*(const __attribute__((address_space(3))) bf16x8*)(kp+6656);
}
__device__ __forceinline__ void kload2(bf16x8*kf,lds_cptr kp,int j){ kf[2*j]=*(const __attribute__((address_space(3))) bf16x8*)(kp+j*2048); kf[2*j+1]=*(const __attribute__((address_space(3))) bf16x8*)(kp+j*2048+512); }
__device__ __forceinline__ s16x4 vtr(lds_cptr p){ return __builtin_bit_cast(s16x4,__builtin_amdgcn_ds_read_tr16_b64_v4i16((__attribute__((address_space(3))) v4i16_t*)p)); }
__device__ __forceinline__ float rowmax(const f32x16&p0,const f32x16&p1){
  float a=max3f(p0[0],p0[1],p1[0]),b=max3f(p0[2],p0[3],p1[1]);a=max3f(a,p1[2],p1[3]);
  #pragma unroll
  for(int r=4;r<16;r+=4){a=max3f(a,p0[r],p0[r+1]);b=max3f(b,p0[r+2],p0[r+3]);a=max3f(a,p1[r],p1[r+1]);b=max3f(b,p1[r+2],p1[r+3]);}
  const float m=max2f(a,b);
  auto rr=__builtin_amdgcn_permlane32_swap(__float_as_uint(m),__float_as_uint(m),false,false);
  return max2f(__uint_as_float(rr[0]),__uint_as_float(rr[1]));
}
__device__ __forceinline__ void pv(f32x16*o,int vb,bf16x8 pa0,bf16x8 pa1,bf16x8 pa2,bf16x8 pa3){
  #pragma unroll
  for(int d0=0;d0<2;++d0){s16x4 lo[4],hi[4];
    #pragma unroll
    for(int ks=0;ks<4;++ks){
      asm volatile("ds_read_b64_tr_b16 %0,%1 offset:%c2":"=&v"(lo[ks]):"v"(vb),"i"(d0*4096+ks*1024):"memory");
      asm volatile("ds_read_b64_tr_b16 %0,%1 offset:%c2":"=&v"(hi[ks]):"v"(vb),"i"(d0*4096+ks*1024+512):"memory");}
    asm volatile("s_waitcnt lgkmcnt(0)":::"memory");SBAR();
    #define PK(k) (bf16x8){lo[k][0],lo[k][1],lo[k][2],lo[k][3],hi[k][0],hi[k][1],hi[k][2],hi[k][3]}
    o[d0]=__builtin_amdgcn_mfma_f32_32x32x16_bf16(pa0,PK(0),o[d0],0,0,0);
    o[d0]=__builtin_amdgcn_mfma_f32_32x32x16_bf16(pa1,PK(1),o[d0],0,0,0);
    o[d0]=__builtin_amdgcn_mfma_f32_32x32x16_bf16(pa2,PK(2),o[d0],0,0,0);
    o[d0]=__builtin_amdgcn_mfma_f32_32x32x16_bf16(pa3,PK(3),o[d0],0,0,0);
    #undef PK
  }
}

#ifndef ATTN_STORE16
#define ATTN_STORE16(p,v) (*(u32x4*)(p)=(v))
#endif
template<int THRL> __device__ __forceinline__ void attn_unit(int b,int h,int qb,const bf16*Q,const bf16*__restrict__ K,const bf16*__restrict__ V,bf16*O,const bf16*__restrict__ KM,float*SSQ,char*shm){
  int tid_=threadIdx.x; asm volatile("":"+v"(tid_)); const int tid=tid_,lane=tid&63,r32=lane&31,hi=lane>>5; const int wid=__builtin_amdgcn_readfirstlane(tid>>6);
  const long rowbase=(long)b*SEQ; const int q0=qb*QB;
  const bf16*Qw=Q+(rowbase+q0+wid*QBLK)*PQ+h*D;
  const bf16*Kh=K+rowbase*PQ+h*D,*Vh=V+rowbase*PQ+h*D;
  const unsigned lds0=(unsigned)(uintptr_t)shm;
  float*wsf=(float*)(shm+LDS_WS)+wid*64;
  const bf16*ksrc=Kh+(long)lane*PQ+wid*8;
  const bf16*vsrc=Vh+(long)(16*(wid&3)+(lane>>2))*PQ+(wid>>2)*32+(lane&3)*8;
  const unsigned kdst=lds0+LDS_K+wid*1024, vdst=lds0+LDS_V+wid*1024;
  #define KT(t) (((t)<4)?(NT-4+(t)):((t)-4))
  #define DMA_K(t,slot) glds16(ksrc+(long)KT(t)*KVBLK*PQ,(unsigned)__builtin_amdgcn_readfirstlane(kdst+(slot)))
  #define DMA_V(t,slot) glds16(vsrc+(long)KT(t)*KVBLK*PQ,(unsigned)__builtin_amdgcn_readfirstlane(vdst+(slot)))
  const int vb0=(int)(lds0+LDS_V)+((lane>>4)&1)*32+(lane&3)*8+(4*hi+((lane&15)>>2))*64;
  const char*Kbase=shm+LDS_K; bf16x8 kf[8];
  const lds_cptr shm3=(lds_cptr)shm; const lds_cptr kp0=shm3+LDS_K+hi*1024+r32*16; const lds_cptr vp0=shm3+LDS_V+((lane>>4)&1)*32+(lane&3)*8+(4*hi+((lane&15)>>2))*64;
  const int NT=(q0+QB)/KVBLK;
  { const bf16*kmsrc=KM+((long)(b*NHEAD+h)*16+(lane&15))*D+wid*8; glds16(kmsrc,(unsigned)__builtin_amdgcn_readfirstlane(lds0+LDS_OST+wid*1024)); }
  DMA_K(0,0);DMA_V(0,0);DMA_K(1,SLOTB);
  bf16x8 qr[4];
  #pragma unroll
  for(int d0=0;d0<4;++d0)qr[d0]=*reinterpret_cast<const bf16x8*>(&Qw[(long)r32*PQ+d0*16+hi*8]);
  float mhat=0.f,l_reg=0.f;f32x16 o[2];o[0]=f32x16{};o[1]=f32x16{};f32x16 negm=f32x16{};asm volatile("":"+v"(negm));
  const int qrel=wid*QBLK+r32;
  #define CMASK(P0,P1,t) do{ if((t)<4)cmask(P0,P1,(t),qrel,hi); }while(0)
  bool resc=false;
  #define START(P0,P1) do{ const float rm=rowmax(P0,P1); resc=false; \
    { const float dl=rm; mhat=fadd_s(mhat,dl); \
      _Pragma("unroll") for(int r=0;r<16;++r){P0[r]=fsub_s(P0[r],dl);P1[r]=fsub_s(P1[r],dl);} \
      _Pragma("unroll") for(int r=0;r<16;++r)negm[r]=-mhat; asm volatile("":"+v"(negm)); } \
    _Pragma("unroll") for(int r=0;r<16;++r)P0[r]=__builtin_amdgcn_exp2f(P0[r]); }while(0)
  #define RESC() do{ if(resc){ asm volatile("s_waitcnt lgkmcnt(0)":::"memory"); \
      _Pragma("unroll") for(int d_=0;d_<2;++d_) _Pragma("unroll") for(int r=0;r<16;++r)o[d_][r]*=wsf[crow(r,hi)]; } }while(0)
  f32x16 pA0,pA1,pB0,pB1;
  int sl_prev=0,sl_cur=0,sl_next=SLOTB;
  #define ROT() do{sl_prev=sl_cur;sl_cur=sl_next;sl_next=(sl_next==(NSLOT-1)*SLOTB)?0:sl_next+SLOTB;}while(0)
  DMA_K(2,2*SLOTB);
  WAIT_BAR(3);
  unsigned selmask=0u;
  { f32x16 g0=f32x16{}; const char*kb=shm+LDS_OST+hi*1024+r32*16;
    _Pragma("unroll") for(int d0=0;d0<4;++d0){ const bf16x8 b0=*reinterpret_cast<const bf16x8*>(kb+d0*2048); g0=__builtin_amdgcn_mfma_f32_32x32x16_bf16(b0,qr[d0],g0,0,0,0); }
    float own[8],oth[8],gv[16];
    _Pragma("unroll") for(int r=0;r<8;++r){ own[r]=g0[r]; oth[r]=__shfl_xor(own[r],32); }
    _Pragma("unroll") for(int j=0;j<4;++j){ gv[j]=hi?oth[j]:own[j]; gv[4+j]=hi?own[j]:oth[j]; gv[8+j]=hi?oth[4+j]:own[4+j]; gv[12+j]=hi?own[4+j]:oth[4+j]; }
    _Pragma("unroll") for(int j=0;j<16;++j) if(j>=qb) gv[j]=-INFINITY;
    _Pragma("unroll") for(int rnd=0;rnd<3;++rnd){ float m=gv[0]; _Pragma("unroll") for(int j=1;j<16;++j)m=fmaxf(m,gv[j]);
      bool found=!(m>-INFINITY); _Pragma("unroll") for(int j=0;j<16;++j){ const bool hit=!found&&(gv[j]==m); if(hit){selmask|=(1u<<j);gv[j]=-INFINITY;} found=found||hit; } } }
  qkt(pA0,pA1,Kbase,qr,negm,r32,hi);asm volatile("s_nop 15\n\ts_nop 7":"+v"(pA0),"+v"(pA1));CMASK(pA0,pA1,0);
  START(pA0,pA1);
  _Pragma("unroll") for(int r=0;r<16;++r)pA1[r]=__builtin_amdgcn_exp2f(pA1[r]);
  WAIT_BAR(0);
  DMA_K(3,0);DMA_V(1,SLOTB);
  ROT();
  kload8(kf,kp0+sl_cur);
  WAIT_BAR(2);
  s16x4 vlo[8],vhi[8]; u32x4 pw0,pw1,pw2,pw3;
  #define PKW(P,B) cvtpk_s(P[B],P[B+1])
  #define PAF(k) __builtin_bit_cast(bf16x8,pw##k)
  #define VFR(i) (bf16x8){vlo[i][0],vlo[i][1],vlo[i][2],vlo[i][3],vhi[i][0],vhi[i][1],vhi[i][2],vhi[i][3]}
  #define PIN(x) asm volatile("":"+v"(x))
  #define MX3(a,b,c) __builtin_fmaxf(__builtin_fmaxf((a),(b)),(c))
  #define GAPA(MF,A0,A1,A2,A3,W0,W1,PW) do{ MF; sacc+=A0; sacc+=A1; sacc+=A2; sacc+=A3; PIN(sacc); W0; W1; PIN(PW); SBAR(); }while(0)
  #define EX(v) __builtin_amdgcn_exp2f(v)
  #define GAPB(MF,X,B) do{ MF; X[B]=EX(X[B]); X[B+1]=EX(X[B+1]); X[B+2]=EX(X[B+2]); X[B+3]=EX(X[B+3]); PIN(X); SBAR(); }while(0)
  #define VRD(i) do{ vlo[i]=vtr(vp_+(((i)>>2)*4096+((i)&3)*1024)); vhi[i]=vtr(vp_+(((i)>>2)*4096+((i)&3)*1024+512)); }while(0)
  #define KRD(G,j) do{ if(G){ kload2(kf,kp0+sl_next,j); SBAR(); } }while(0)
  #define STEP(C0,C1,P0,P1,t,GK,GV,GL) do{ SBAR(); \
    { const bool on_=((t)<4)||(((selmask>>(((t)-4)>>2))&1u)!=0u); const float nm_=on_?-mhat:-1.0e30f; _Pragma("unroll") for(int r=0;r<16;++r)negm[r]=nm_; asm volatile("":"+v"(negm)); } \
    const lds_cptr vp_=vp0+sl_prev; \
    VRD(0); SBAR(); float sacc=(P0[0]+P0[1]); \
    GAPA(C0=__builtin_amdgcn_mfma_f32_32x32x16_bf16(kf[0],qr[0],negm,0,0,0), P0[2],P0[3],P0[4],P0[5],     pw0[0]=PKW(P0,0), pw0[1]=PKW(P0,2), pw0); \
    VRD(4); SBAR(); GAPA(C1=__builtin_amdgcn_mfma_f32_32x32x16_bf16(kf[1],qr[0],negm,0,0,0), P0[6],P0[7],P0[8],P0[9],     pw0[2]=PKW(P0,4), pw0[3]=PKW(P0,6), pw0); \
    VRD(1); SBAR(); GAPA(C0=__builtin_amdgcn_mfma_f32_32x32x16_bf16(kf[2],qr[1],C0,0,0,0),   P0[10],P0[11],P0[12],P0[13], pw1[0]=PKW(P0,8), pw1[1]=PKW(P0,10), pw1); \
    VRD(5); SBAR(); GAPA(C1=__builtin_amdgcn_mfma_f32_32x32x16_bf16(kf[3],qr[1],C1,0,0,0),   P0[14],P0[15],P1[0],P1[1],   pw1[2]=PKW(P0,12),pw1[3]=PKW(P0,14), pw1); \
    VRD(2); SBAR(); GAPA(C0=__builtin_amdgcn_mfma_f32_32x32x16_bf16(kf[4],qr[2],C0,0,0,0),   P1[2],P1[3],P1[4],P1[5],     pw2[0]=PKW(P1,0), pw2[1]=PKW(P1,2), pw2); \
    VRD(6); SBAR(); GAPA(C1=__builtin_amdgcn_mfma_f32_32x32x16_bf16(kf[5],qr[2],C1,0,0,0),   P1[6],P1[7],P1[8],P1[9],     pw2[2]=PKW(P1,4), pw2[3]=PKW(P1,6), pw2); \
    VRD(3); SBAR(); GAPA(C0=__builtin_amdgcn_mfma_f32_32x32x16_bf16(kf[6],qr[3],C0,0,0,0),   P1[10],P1[11],P1[12],P1[13], pw3[0]=PKW(P1,8), pw3[1]=PKW(P1,10), pw3); \
    VRD(7); SBAR(); GAPA(C1=__builtin_amdgcn_mfma_f32_32x32x16_bf16(kf[7],qr[3],C1,0,0,0),   P1[14],P1[15],0.f,0.f,       pw3[2]=PKW(P1,12),pw3[3]=PKW(P1,14), pw3); \
    l_reg+=sacc; \
    if(GK){DMA_K((t)+3,sl_cur);} if(GV){DMA_V((t)+1,sl_next);} \
    CMASK(C0,C1,t); \
    { float a=MX3(C0[0],C0[1],C1[0]),b=MX3(C0[2],C0[3],C1[1]); a=MX3(a,C1[2],C1[3]); \
      _Pragma("unroll") for(int r=4;r<16;r+=4){a=MX3(a,C0[r],C0[r+1]);b=MX3(b,C0[r+2],C0[r+3]);a=MX3(a,C1[r],C1[r+1]);b=MX3(b,C1[r+2],C1[r+3]);} \
      float rm=__builtin_fmaxf(a,b); { auto rr=__builtin_amdgcn_permlane32_swap(__float_as_uint(rm),__float_as_uint(rm),false,false); rm=__builtin_fmaxf(__uint_as_float(rr[0]),__uint_as_float(rr[1])); } \
      resc=false; \
      if(__builtin_expect(__any(rm>(float)THRL),0)){ const float dl=__builtin_fmaxf(rm,0.f); mhat+=dl; \
        _Pragma("unroll") for(int r=0;r<16;++r){C0[r]-=dl;C1[r]-=dl;} \
        _Pragma("unroll") for(int r=0;r<16;++r)negm[r]=-mhat; asm volatile("":"+v"(negm)); \
        const float f=__builtin_amdgcn_exp2f(-dl); l_reg*=f; if(hi==0)wsf[r32]=f; resc=true; } } \
    SBAR(); \
    GAPB(o[0]=__builtin_amdgcn_mfma_f32_32x32x16_bf16(PAF(0),VFR(0),o[0],0,0,0), C0,0); \
    GAPB(o[1]=__builtin_amdgcn_mfma_f32_32x32x16_bf16(PAF(0),VFR(4),o[1],0,0,0), C0,4); \
    KRD(GL,0); GAPB(o[0]=__builtin_amdgcn_mfma_f32_32x32x16_bf16(PAF(1),VFR(1),o[0],0,0,0), C0,8); \
    KRD(GL,1); GAPB(o[1]=__builtin_amdgcn_mfma_f32_32x32x16_bf16(PAF(1),VFR(5),o[1],0,0,0), C0,12); \
    KRD(GL,2); GAPB(o[0]=__builtin_amdgcn_mfma_f32_32x32x16_bf16(PAF(2),VFR(2),o[0],0,0,0), C1,0); \
    KRD(GL,3); GAPB(o[1]=__builtin_amdgcn_mfma_f32_32x32x16_bf16(PAF(2),VFR(6),o[1],0,0,0), C1,4); \
    GAPB(o[0]=__builtin_amdgcn_mfma_f32_32x32x16_bf16(PAF(3),VFR(3),o[0],0,0,0), C1,8); \
    GAPB(o[1]=__builtin_amdgcn_mfma_f32_32x32x16_bf16(PAF(3),VFR(7),o[1],0,0,0), C1,12); \
    }while(0)
  int t=1;
  for(;t+5<NT;t+=2){
    STEP(pB0,pB1,pA0,pA1,t,true,true,true);     WAIT_BAR(2); RESC(); ROT();
    STEP(pA0,pA1,pB0,pB1,t+1,true,true,true);   WAIT_BAR(2); RESC(); ROT();
  }
  #define ENDW(tt) do{ if((tt)+3<NT){WAIT_BAR(2);} else if((tt)+2<NT){WAIT_BAR(1);} else {WAIT_BAR(0);} }while(0)
  for(;t+1<NT;t+=2){
    STEP(pB0,pB1,pA0,pA1,t,(t+3<NT),(t+1<NT),(t+1<NT));       ENDW(t);   RESC(); ROT();
    STEP(pA0,pA1,pB0,pB1,t+1,(t+4<NT),(t+2<NT),(t+2<NT));     ENDW(t+1); RESC(); ROT();
  }
  STEP(pB0,pB1,pA0,pA1,NT-1,false,false,false); RESC();
  { float sacc=pB0[0]+pB0[1]; _Pragma("unroll") for(int r=2;r<16;++r)sacc+=pB0[r]; _Pragma("unroll") for(int r=0;r<16;++r)sacc+=pB1[r]; l_reg+=sacc;
    pw0=(u32x4){PKW(pB0,0),PKW(pB0,2),PKW(pB0,4),PKW(pB0,6)};pw1=(u32x4){PKW(pB0,8),PKW(pB0,10),PKW(pB0,12),PKW(pB0,14)};pw2=(u32x4){PKW(pB1,0),PKW(pB1,2),PKW(pB1,4),PKW(pB1,6)};pw3=(u32x4){PKW(pB1,8),PKW(pB1,10),PKW(pB1,12),PKW(pB1,14)};
    SBAR(); pv(o,vb0+sl_cur,PAF(0),PAF(1),PAF(2),PAF(3)); }
  #undef PKW
  #undef PAF
  #undef VFR
  #undef PIN
  #undef MX3
  #undef GAPA
  #undef GAPB
  #undef EX
  #undef VRD
  #undef KRD
  #undef STEP
  #undef ENDW
  {auto rr=__builtin_amdgcn_permlane32_swap(__float_as_uint(l_reg),__float_as_uint(l_reg),false,false);l_reg=__uint_as_float(rr[0])+__uint_as_float(rr[1]);}
  if(hi==0)wsf[32+r32]=l_reg;asm volatile("s_waitcnt lgkmcnt(0)":::"memory");
  float rli[16];
  #pragma unroll
  for(int r=0;r<16;++r)rli[r]=__builtin_amdgcn_rcpf(wsf[32+crow(r,hi)]);
  bf16*Ow=O+(rowbase+q0+wid*QBLK)*PO+h*D; float*Sw=SSQ+(rowbase+q0+wid*QBLK)*16+h;
  { bf16*stg=(bf16*)(shm+LDS_OST)+wid*2048;
    #pragma unroll
    for(int r=0;r<16;++r){const int orow=crow(r,hi);
      #pragma unroll
      for(int d0=0;d0<2;++d0)stg[orow*64+d0*32+r32]=(bf16)f2bf(o[d0][r]*rli[r]);}
    asm volatile("s_waitcnt lgkmcnt(0)":::"memory");
    #pragma unroll
    for(int i=0;i<4;++i){const int row=i*8+(lane>>3),ch=lane&7; const u32x4 v=*(const u32x4*)(stg+row*64+ch*8); ATTN_STORE16(Ow+(long)row*PO+ch*8,v);
      float q=0.f; _Pragma("unroll") for(int e=0;e<4;++e){ const float lo=__uint_as_float(v[e]<<16),hi2=__uint_as_float(v[e]&0xffff0000u); q+=lo*lo+hi2*hi2; }
      q+=__shfl_xor(q,1); q+=__shfl_xor(q,2); q+=__shfl_xor(q,4); if(ch==0)Sw[(long)row*16]=q; } }
  asm volatile("s_waitcnt lgkmcnt(0)\n\ts_barrier":::"memory");
  #undef DMA_K
  #undef KT
  #undef DMA_V
  #undef CMASK
  #undef START
  #undef RESC
  #undef ROT
}
constexpr int ATTN_LDS_BYTES=LDS_BYTES;
struct AttnTensors { const bf16* Q; const bf16* K; const bf16* V; bf16* O; const bf16* KM; float* SSQ; };
struct AttnUnit { int bh; int qb; };
struct StaticOrder {
  int vcu, nvcu;
  __device__ __forceinline__ explicit StaticOrder(int grid,int block):vcu((grid%8==0)?(block%8)*(grid/8)+block/8:block),nvcu(grid){}
  __device__ __forceinline__ bool next(int i,AttnUnit&u)const{ const int item=vcu+(i>>2)*nvcu; if(item>=256)return false; const int s=item&3,j=i&3; u.bh=item>>2; u.qb=(j==0)?15-s:(j==1)?8+s:(j==2)?7-s:s; return true; }
  __device__ __forceinline__ void a_ready(const AttnUnit&)const{}
  __device__ __forceinline__ void done(const AttnUnit&)const{}
};
template<class Sched,int THRL=8> __device__ __forceinline__ void attn_phase(char*lds,const AttnTensors&T,const Sched&S){
  AttnUnit u;
  for(int i=0;S.next(i,u);++i){ S.a_ready(u); attn_unit<THRL>(u.bh/NHEAD,u.bh%NHEAD,u.qb,T.Q,T.K,T.V,T.O,T.KM,T.SSQ,lds); S.done(u); }
}
#undef SBAR
#undef WAIT_BAR
}
namespace mk {
#define XB_TMO      128
#define XB_XCNT(j)  (256  + 64 * (j))
#define XB_XSUB(j)  (1280 + 64 * (j))
#define XB_XGEN(j)  (2304 + 64 * (j))
#define XB_TOP      3328
#define XB_TOPGEN   3392
#define XCD_BAR_WORDS 3456
#define XB_SPIN_CAP (1u << 18)

__device__ __forceinline__ unsigned xb_ld(unsigned* p)              { return __hip_atomic_load(p, __ATOMIC_RELAXED, __HIP_MEMORY_SCOPE_AGENT); }
__device__ __forceinline__ unsigned xb_add(unsigned* p, unsigned v) { return __hip_atomic_fetch_add(p, v, __ATOMIC_RELAXED, __HIP_MEMORY_SCOPE_AGENT); }
__device__ __forceinline__ unsigned xb_xcc_id() { return (unsigned)__builtin_amdgcn_s_getreg((3 << 11) | 20) & 0xFu; }
#define XB_SPIN(cond, bar) do { unsigned _sp = 0; while (cond) { __builtin_amdgcn_s_sleep(1); \
    if ((++_sp & 255u) == 0u) { if (xb_ld(&(bar)[XB_TMO])) break; if (_sp > XB_SPIN_CAP) { atomicAdd(&(bar)[XB_TMO], 1u); break; } } } } while (0)

struct XcdBarrier {
    unsigned* bar; unsigned x;
    volatile LAS unsigned* st;
};

__device__ __forceinline__ XcdBarrier xcd_barrier_post(unsigned* bar, volatile LAS unsigned* st) {
    XcdBarrier b; b.bar = bar; b.x = xb_xcc_id(); b.st = st;
    if (threadIdx.x == 0) (void)xb_add(&bar[XB_XCNT(b.x)], 1u);
    return b;
}
__device__ __forceinline__ void xcd_barrier_complete(unsigned* bar, unsigned x, unsigned& nloc, unsigned& nx) {
    const unsigned G = gridDim.x * gridDim.y * gridDim.z;
    unsigned sum, cnt, mine, sp = 0u;
    for (;;) {
        sum = 0u; cnt = 0u; mine = 0u;
#pragma unroll
        for (unsigned j = 0; j < 16; ++j) { const unsigned c = xb_ld(&bar[XB_XCNT(j)]); sum += c; cnt += (c > 0u) ? 1u : 0u; mine = (j == x) ? c : mine; }
        if (sum == G) break;
        __builtin_amdgcn_s_sleep(1);
        if ((++sp & 255u) == 0u) { if (xb_ld(&bar[XB_TMO])) break; if (sp > XB_SPIN_CAP) { atomicAdd(&bar[XB_TMO], 1u); break; } }
    }
    nloc = mine > 0u ? mine : 1u; nx = cnt > 0u ? cnt : 1u;
}

__device__ __forceinline__ void xcd_barrier(const XcdBarrier& b) {
    asm volatile("s_waitcnt vmcnt(0)" ::: "memory");
    __syncthreads();
    if (threadIdx.x == 0) {
        unsigned* bar = b.bar;
        __builtin_amdgcn_s_waitcnt(0);
        unsigned nloc = b.st[0], nx = b.st[1];
        if (nloc == 0u) { xcd_barrier_complete(bar, b.x, nloc, nx); b.st[0] = nloc; b.st[1] = nx; }
        const unsigned old = xb_add(&bar[XB_XSUB(b.x)], 1u);
        const unsigned gen = old / nloc;
        if (old + 1u == (gen + 1u) * nloc) {
            __builtin_amdgcn_fence(__ATOMIC_RELEASE, "agent");
            asm volatile("s_waitcnt vmcnt(0)" ::: "memory");
            const unsigned og = xb_add(&bar[XB_TOP], 1u);
            const unsigned tg = og / nx;
            if (og + 1u == (tg + 1u) * nx) xb_add(&bar[XB_TOPGEN], 1u);
            else XB_SPIN(xb_ld(&bar[XB_TOPGEN]) == tg, bar);
            __builtin_amdgcn_fence(__ATOMIC_ACQUIRE, "agent");
            xb_add(&bar[XB_XGEN(b.x)], 1u);
            asm volatile("s_waitcnt vmcnt(0)" ::: "memory");
        } else {
            XB_SPIN(xb_ld(&bar[XB_XGEN(b.x)]) == gen, bar);
            __builtin_amdgcn_fence(__ATOMIC_ACQUIRE, "agent");
            asm volatile("s_waitcnt vmcnt(0)" ::: "memory");
        }
    }
    __syncthreads();
}
#define RLX_AGENT __ATOMIC_RELAXED, __HIP_MEMORY_SCOPE_AGENT
#define LDS_WAIT() asm volatile("s_waitcnt lgkmcnt(0)" ::: "memory")
#define VM_WAIT() asm volatile("s_waitcnt vmcnt(0)" ::: "memory")
constexpr int NWAVES = 8;
struct Args { const float* in[23]; float* out; unsigned char* ws; int ph_lo, ph_hi, skip, pad; };
struct Frame {
    LAS unsigned char* lds; unsigned char* lds_gen; volatile LAS unsigned* MISC; gu32* ctl;
    int tid, lane, wave, vcu, G;
};
__device__ __forceinline__ float wave_sum(float v) {
#pragma unroll
    for (int o = 1; o < 64; o <<= 1) v += __shfl_xor(v, o);
    return v;
}
__device__ __forceinline__ void p0_transpose_item(const float* W, int K, int N, bf16* WT, int k0, int n0, int drow0, const float* kscale, LAS float* scr, int lane) {
#pragma unroll 8
    for (int i = 0; i < 32; ++i) { const int kk = 2 * i + (lane >> 5); float v = W[(size_t)(k0 + kk) * N + n0 + (lane & 31)]; if (kscale) v *= kscale[k0 + kk]; scr[kk * 33 + (lane & 31)] = v; }
    LDS_WAIT(); asm volatile("" ::: "memory");
    const int c = lane & 7;
#pragma unroll
    for (int j = 0; j < 4; ++j) { const int n = (lane >> 3) + 8 * j; const LAS float* s = scr + (8 * c) * 33 + n;
        u32x4 o; o.x = pk2(s[0 * 33], s[1 * 33]); o.y = pk2(s[2 * 33], s[3 * 33]); o.z = pk2(s[4 * 33], s[5 * 33]); o.w = pk2(s[6 * 33], s[7 * 33]);
        *(GAS u32x4*)(WT + (size_t)(drow0 + n) * K + k0 + 8 * c) = o; }
    LDS_WAIT(); asm volatile("" ::: "memory");
}
__device__ __forceinline__ void p0_prologue(Frame& F, const __attribute__((address_space(4))) Args* a) {
    LAS float* scr = (LAS float*)(F.lds + RING_OFF + F.wave * 16384);
    const int gw = F.vcu * NWAVES + F.wave, NGW = F.G * NWAVES;
    unsigned char* ws = a->ws;
    constexpr int I_IN = 16 * 80, I_OUT = 16 * 32, I_G = 16 * 256, I_U = 16 * 256, I_D = 16 * 256, I_L = I_IN + I_OUT + I_G + I_U + I_D;
    for (int it = gw; it < 2 * I_L; it += NGW) {
        const int l = it / I_L; int r = it % I_L;
        if (r < I_IN) { const int kb = r / 80, nb = r % 80; p0_transpose_item(a->in[1] + (size_t)l * D * NPROJ, D, NPROJ, (bf16*)(ws + WS_WIN) + (size_t)l * NPROJ * D, 64 * kb, 32 * nb, 32 * nb, nullptr, scr, F.lane); continue; } r -= I_IN;
        if (r < I_OUT) { const int kb = r / 32, nb = r % 32; const float* ks = (kb < 8) ? a->in[9] + l * 512 : a->in[10] + l * 512 - 512;
            p0_transpose_item(a->in[11] + (size_t)l * D * D, D, D, (bf16*)(ws + WS_WOUT) + (size_t)l * D * D, 64 * kb, 32 * nb, 32 * nb, ks, scr, F.lane); continue; } r -= I_OUT;
        if (r < I_G + I_U) { const int up = r >= I_G; if (up) r -= I_G; const int e = r / 256, q = r % 256, kb = q / 16, nb = q % 16, n0 = 32 * nb;
            p0_transpose_item(a->in[up ? 19 : 18] + ((size_t)l * 16 + e) * D * DEXP, D, DEXP, (bf16*)(ws + WS_WGU) + ((size_t)l * 16 + e) * 1024 * D, 64 * kb, n0, (n0 >> 7) * 256 + (up ? 128 : 0) + (n0 & 127), nullptr, scr, F.lane); continue; } r -= I_G + I_U;
        { const int e = r / 256, q = r % 256, kb = q / 32, nb = q % 32;
            p0_transpose_item(a->in[20] + ((size_t)l * 16 + e) * DEXP * D, DEXP, D, (bf16*)(ws + WS_WD) + ((size_t)l * 16 + e) * D * DEXP, 64 * kb, 32 * nb, 32 * nb, nullptr, scr, F.lane); }
    }
    const int gt = F.vcu * (NWAVES * 64) + F.tid, NGT = F.G * NWAVES * 64;
    for (int i = gt; i < 2 * 2 * 8 * 64 * 64; i += NGT) { const int c = i & 63, d = (i >> 6) & 63, n = (i >> 12) & 7, mat = (i >> 15) & 1, l = i >> 16;
        ((bf16*)(ws + WS_WRG))[i] = (bf16)f2bf(a->in[mat ? 6 : 4][(((size_t)l * 8 + n) * 64 + c) * 64 + d]); }
    for (int i = gt; i < 2 * 512; i += NGT) ((float*)(ws + WS_SP))[i] = log1pf(expf(-a->in[8][i]));
    for (int i = gt; i < NS * 8; i += NGT) { const int j = i & 7, s = i >> 3; const float inv = powf(500000.0f, -(float)j / 8.0f), ang = (float)s * inv; ((float2*)(ws + WS_ROPE))[i] = make_float2(cosf(ang), sinf(ang)); }
    for (int m = gw; m < T; m += NGW) { const GAS f32x4* xr = (const GAS f32x4*)(a->in[0] + (size_t)m * D) + F.lane; GAS u32x2* o = (GAS u32x2*)((bf16*)(ws + WS_XB) + (size_t)m * D) + F.lane;
#pragma unroll
        for (int j = 0; j < 4; ++j) { const f32x4 v = xr[64 * j]; o[64 * j] = (u32x2){pk2(v[0], v[1]), pk2(v[2], v[3])}; } }
}
__device__ __forceinline__ void kmean_item(Frame& F, int item, const bf16* PROJ, bf16* KM) {
    const int b = item >> 4, blk = item & 15, cg = F.tid & 63, rg = F.tid >> 6;
    const bf16* base = PROJ + ((size_t)b * NS + blk * 256) * NPROJ + KOFF + cg * 8;
    float s[8] = {0.f, 0.f, 0.f, 0.f, 0.f, 0.f, 0.f, 0.f};
#pragma unroll 4
    for (int i = 0; i < 32; ++i) { const u32x4 v = *(const u32x4*)(base + (size_t)(rg + 8 * i) * NPROJ);
#pragma unroll
        for (int e = 0; e < 4; ++e) { s[2 * e] += __uint_as_float(v[e] << 16); s[2 * e + 1] += __uint_as_float(v[e] & 0xffff0000u); } }
    LAS float* part = (LAS float*)(F.lds + RING_OFF);
#pragma unroll
    for (int e = 0; e < 8; ++e) part[rg * 512 + cg * 8 + e] = s[e];
    __syncthreads();
    { const int col = F.tid; float t = 0.f;
#pragma unroll
        for (int r = 0; r < 8; ++r) t += part[r * 512 + col];
        KM[(((size_t)b * NH + (col >> 6)) * NBLK + blk) * HD + (col & 63)] = (bf16)f2bf(t * (1.f / 256.f)); }
    __syncthreads();
}
constexpr int RG_PITCH = 144, RG_XR = 0, RG_XC = 260 * RG_PITCH, RG_GR = RG_XC + 256 * RG_PITCH, RG_WC = RG_GR + 256 * RG_PITCH, RG_END = RG_WC + 8 * 64 * 8;
static_assert(RG_END <= RING_BYTES && (RG_XC % 16) == 0 && (RG_GR % 16) == 0 && (RG_WC % 16) == 0, "rglru LDS map");
template <bool FINAL>
__device__ __forceinline__ void rglru_unit(Frame& F, int b, int ck, int n, const bf16* PROJ, const float* conv_w, const float* conv_b, const bf16* WRG, const float* b_a, const float* b_i,
                                           const float* sp, float2* SUMM, bf16* MIX, float* SSQ) {
    LAS unsigned char* L = F.lds + RING_OFF;
    const int tid = F.tid, lane = F.lane, w = F.wave, r32 = lane & 31, hh = lane >> 5;
    const size_t t0 = (size_t)b * NS + (size_t)ck * 256;
    for (int it = tid; it < 259 * 8; it += 512) { const int j = it >> 3, c8 = it & 7; u32x4 v = (u32x4){0u, 0u, 0u, 0u};
        if (!(ck == 0 && j < 3)) v = *(const u32x4*)(PROJ + (t0 + j - 3) * NPROJ + XROFF + n * 64 + c8 * 8);
        *(LAS u32x4*)(L + RG_XR + j * RG_PITCH + c8 * 16) = v; }
    if (FINAL) for (int it = tid; it < 256 * 8; it += 512) { const int j = it >> 3, c8 = it & 7;
        *(LAS u32x4*)(L + RG_GR + j * RG_PITCH + c8 * 16) = *(const u32x4*)(PROJ + (t0 + j) * NPROJ + GROFF + n * 64 + c8 * 8); }
    __syncthreads();
    { const int c8 = tid & 7; float cw[4][8], cb[8];
#pragma unroll
        for (int i = 0; i < 8; ++i) { cb[i] = conv_b[n * 64 + c8 * 8 + i];
#pragma unroll
            for (int q = 0; q < 4; ++q) cw[q][i] = conv_w[q * 512 + n * 64 + c8 * 8 + i]; }
#pragma unroll
        for (int k = 0; k < 4; ++k) { const int j = (tid >> 3) + 64 * k; float xc[8];
#pragma unroll
            for (int i = 0; i < 8; ++i) xc[i] = cb[i];
#pragma unroll
            for (int q = 0; q < 4; ++q) { const u32x4 v = *(const LAS u32x4*)(L + RG_XR + (j + q) * RG_PITCH + c8 * 16);
#pragma unroll
                for (int e = 0; e < 4; ++e) { xc[2 * e] += cw[q][2 * e] * __uint_as_float(v[e] << 16); xc[2 * e + 1] += cw[q][2 * e + 1] * __uint_as_float(v[e] & 0xffff0000u); } }
            *(LAS u32x4*)(L + RG_XC + j * RG_PITCH + c8 * 16) = (u32x4){pk2(xc[0], xc[1]), pk2(xc[2], xc[3]), pk2(xc[4], xc[5]), pk2(xc[6], xc[7])}; } }
    __syncthreads();
    f32x16 ga[2], gi[2];
#pragma unroll
    for (int cb2 = 0; cb2 < 2; ++cb2) { ga[cb2] = f32x16{}; gi[cb2] = f32x16{}; }
#pragma unroll
    for (int ks = 0; ks < 4; ++ks) { const bf16x8 af = *(const LAS bf16x8*)(L + RG_XC + (32 * w + r32) * RG_PITCH + (16 * ks + 8 * hh) * 2);
#pragma unroll
        for (int cb2 = 0; cb2 < 2; ++cb2) {
            const bf16x8 ba = *(const bf16x8*)(WRG + ((size_t)(0 * 8 + n) * 64 + cb2 * 32 + r32) * 64 + 16 * ks + 8 * hh);
            const bf16x8 bi = *(const bf16x8*)(WRG + ((size_t)(1 * 8 + n) * 64 + cb2 * 32 + r32) * 64 + 16 * ks + 8 * hh);
            ga[cb2] = __builtin_amdgcn_mfma_f32_32x32x16_bf16(af, ba, ga[cb2], 0, 0, 0);
            gi[cb2] = __builtin_amdgcn_mfma_f32_32x32x16_bf16(af, bi, gi[cb2], 0, 0, 0); } }
    float As[2][4], Hs[2][4];
#pragma unroll
    for (int cb2 = 0; cb2 < 2; ++cb2) { const int d = cb2 * 32 + r32, ch = n * 64 + d; const float bav = b_a[ch], biv = b_i[ch], spv = sp[ch];
#pragma unroll
        for (int r = 0; r < 16; ++r) { const int tt = 32 * w + (r & 3) + 8 * (r >> 2) + 4 * hh;
            const float xcv = bf2f(*(const LAS bf16*)(L + RG_XC + tt * RG_PITCH + d * 2));
            const float rg = __builtin_amdgcn_rcpf(1.f + __expf(-(ga[cb2][r] + bav))), ig = __builtin_amdgcn_rcpf(1.f + __expf(-(gi[cb2][r] + biv)));
            const float la = -8.0f * rg * spv; ga[cb2][r] = __expf(la); gi[cb2][r] = sqrtf(-expm1f(2.f * la)) * (ig * xcv); }
#pragma unroll
        for (int g = 0; g < 4; ++g) { const float a0 = ga[cb2][4 * g], a1 = ga[cb2][4 * g + 1], a2 = ga[cb2][4 * g + 2], a3 = ga[cb2][4 * g + 3];
            As[cb2][g] = (a0 * a1) * (a2 * a3); Hs[cb2][g] = ((gi[cb2][4 * g] * a1 + gi[cb2][4 * g + 1]) * a2 + gi[cb2][4 * g + 2]) * a3 + gi[cb2][4 * g + 3]; } }
    float Ao[2][4], Ho[2][4];
#pragma unroll
    for (int cb2 = 0; cb2 < 2; ++cb2)
#pragma unroll
        for (int g = 0; g < 4; ++g) { Ao[cb2][g] = __shfl_xor(As[cb2][g], 32); Ho[cb2][g] = __shfl_xor(Hs[cb2][g], 32); }
    LAS f32x2* WC = (LAS f32x2*)(L + RG_WC);
    float Ae[2][4], He[2][4], Aod[2][4], Hod[2][4];
#pragma unroll
    for (int cb2 = 0; cb2 < 2; ++cb2) { float Aw = 1.f, Hw = 0.f;
#pragma unroll
        for (int g = 0; g < 4; ++g) { Ae[cb2][g] = hh ? Ao[cb2][g] : As[cb2][g]; He[cb2][g] = hh ? Ho[cb2][g] : Hs[cb2][g]; Aod[cb2][g] = hh ? As[cb2][g] : Ao[cb2][g]; Hod[cb2][g] = hh ? Hs[cb2][g] : Ho[cb2][g];
            Hw = Ae[cb2][g] * Hw + He[cb2][g]; Aw *= Ae[cb2][g]; Hw = Aod[cb2][g] * Hw + Hod[cb2][g]; Aw *= Aod[cb2][g]; }
        if (hh == 0) WC[w * 64 + cb2 * 32 + r32] = (f32x2){Aw, Hw}; }
    __syncthreads();
    float hin[2];
#pragma unroll
    for (int cb2 = 0; cb2 < 2; ++cb2) { const int d = cb2 * 32 + r32; float h = 0.f;
        if (FINAL) { for (int c = 0; c < ck; ++c) { const float2 s = SUMM[((size_t)b * 16 + c) * 512 + n * 64 + d]; h = s.x * h + s.y; } }
        for (int w2 = 0; w2 < w; ++w2) { const f32x2 s = WC[w2 * 64 + d]; h = s.x * h + s.y; }
        hin[cb2] = h;
        if (!FINAL) { if (w == 7 && hh == 0) { float Ac = 1.f, Hc = 0.f;
#pragma unroll
                for (int w2 = 0; w2 < 8; ++w2) { const f32x2 s = WC[w2 * 64 + d]; Hc = s.x * Hc + s.y; Ac *= s.x; }
                SUMM[((size_t)b * 16 + ck) * 512 + n * 64 + d] = make_float2(Ac, Hc); } } }
    if (FINAL) {
#pragma unroll
        for (int cb2 = 0; cb2 < 2; ++cb2) { const int d = cb2 * 32 + r32; float P = hin[cb2];
#pragma unroll
            for (int g = 0; g < 4; ++g) { const float Po = Ae[cb2][g] * P + He[cb2][g]; float h = hh ? Po : P;
#pragma unroll
                for (int i = 0; i < 4; ++i) { const int r = 4 * g + i; const int tt = 32 * w + (r & 3) + 8 * (r >> 2) + 4 * hh; h = ga[cb2][r] * h + gi[cb2][r];
                    const float gv = bf2f(*(const LAS bf16*)(L + RG_GR + tt * RG_PITCH + d * 2));
                    *(LAS bf16*)(L + RG_XC + tt * RG_PITCH + d * 2) = (bf16)f2bf(h * gelu_tanh_f(gv)); }
                P = Aod[cb2][g] * Po + Hod[cb2][g]; } }
        LDS_WAIT(); asm volatile("" ::: "memory");
#pragma unroll
        for (int it = 0; it < 4; ++it) { const int idx = it * 64 + lane, row = idx >> 3, c8 = idx & 7; const u32x4 v = *(const LAS u32x4*)(L + RG_XC + (32 * w + row) * RG_PITCH + c8 * 16);
            float q = 0.f;
#pragma unroll
            for (int e = 0; e < 4; ++e) { const float lo = __uint_as_float(v[e] << 16), hi2 = __uint_as_float(v[e] & 0xffff0000u); q += lo * lo + hi2 * hi2; }
            q += __shfl_xor(q, 1); q += __shfl_xor(q, 2); q += __shfl_xor(q, 4);
            const size_t tok = t0 + 32 * w + row;
            *(u32x4*)(MIX + tok * D + 512 + n * 64 + c8 * 8) = v;
            if (c8 == 0) SSQ[tok * 16 + 8 + n] = q; }
    }
    __syncthreads();
}
constexpr int P5_WR = 0, P5_LCNT = 81920, P5_LBASE = 81920 + 64, P5_DEC = 81920 + 128;
__device__ __forceinline__ void p5_ln_router(Frame& F, const bf16* PRE, const float* g, const float* bb, bf16* X1, const float* wg, const float* bg, const float* we, const float* be,
                                             gu32* gcnt, int* LIST, uint4* TOK) {
    LAS unsigned char* L = F.lds + RING_OFF; LAS float* WR = (LAS float*)(L + P5_WR); LAS unsigned* lcnt = (LAS unsigned*)(L + P5_LCNT); LAS unsigned* lbase = (LAS unsigned*)(L + P5_LBASE); LAS unsigned* dec = (LAS unsigned*)(L + P5_DEC);
    const int tid = F.tid, lane = F.lane, w = F.wave;
    for (int i = tid; i < 4096; i += 512) WR[(i & 3) * 1024 + (i >> 2)] = wg[i];
    for (int i = tid; i < 16384; i += 512) WR[(4 + (i & 15)) * 1024 + (i >> 4)] = we[i];
    float gg[16], gb[16];
#pragma unroll
    for (int j = 0; j < 2; ++j)
#pragma unroll
        for (int q = 0; q < 2; ++q) { const f32x4 a = *(const f32x4*)(g + j * 512 + lane * 8 + q * 4), c = *(const f32x4*)(bb + j * 512 + lane * 8 + q * 4);
#pragma unroll
            for (int e = 0; e < 4; ++e) { gg[j * 8 + q * 4 + e] = a[e]; gb[j * 8 + q * 4 + e] = c[e]; } }
    float bias[20];
#pragma unroll
    for (int o = 0; o < 4; ++o) bias[o] = bg[o];
#pragma unroll
    for (int o = 0; o < 16; ++o) bias[4 + o] = be[o];
    for (int rb = F.vcu; rb < T / 128; rb += F.G) {
        if (tid < 16) lcnt[tid] = 0u;
        __syncthreads();
        for (int i = 0; i < 16; ++i) { const int rl = w * 16 + i; const size_t t = (size_t)rb * 128 + rl;
            float v[16]; float s = 0.f;
#pragma unroll
            for (int j = 0; j < 2; ++j) { const u32x4 raw = *(const u32x4*)(PRE + t * D + j * 512 + lane * 8);
#pragma unroll
                for (int e = 0; e < 4; ++e) { v[j * 8 + 2 * e] = __uint_as_float(raw[e] << 16); v[j * 8 + 2 * e + 1] = __uint_as_float(raw[e] & 0xffff0000u); } }
#pragma unroll
            for (int e = 0; e < 16; ++e) s += v[e];
            const float mu = wave_sum(s) * (1.f / 1024.f); float q = 0.f;
#pragma unroll
            for (int e = 0; e < 16; ++e) { v[e] -= mu; q += v[e] * v[e]; }
            const float rstd = rsqrtf(wave_sum(q) * (1.f / 1024.f) + LN_EPS);
#pragma unroll
            for (int e = 0; e < 16; ++e) v[e] = v[e] * rstd * gg[e] + gb[e];
#pragma unroll
            for (int j = 0; j < 2; ++j) *(u32x4*)(X1 + t * D + j * 512 + lane * 8) = (u32x4){pk2(v[j * 8], v[j * 8 + 1]), pk2(v[j * 8 + 2], v[j * 8 + 3]), pk2(v[j * 8 + 4], v[j * 8 + 5]), pk2(v[j * 8 + 6], v[j * 8 + 7])};
            float lg[20];
#pragma unroll
            for (int o = 0; o < 20; ++o) { float a = 0.f;
#pragma unroll
                for (int j = 0; j < 2; ++j)
#pragma unroll
                    for (int q2 = 0; q2 < 2; ++q2) { const f32x4 wv = *(const LAS f32x4*)(WR + o * 1024 + j * 512 + lane * 8 + q2 * 4);
#pragma unroll
                        for (int e = 0; e < 4; ++e) a += v[j * 8 + q2 * 4 + e] * wv[e]; }
                lg[o] = a; }
#pragma unroll
            for (int o = 0; o < 20; ++o) lg[o] = wave_sum(lg[o]) + bias[o];
            int gi = 0; float gv = lg[0];
#pragma unroll
            for (int o = 1; o < 4; ++o) if (lg[o] > gv) { gi = o; gv = lg[o]; }
            float gs = 0.f;
#pragma unroll
            for (int o = 0; o < 4; ++o) gs += __expf(lg[o] - gv);
            const float gp = 1.f / gs; float l4[4];
#pragma unroll
            for (int o = 0; o < 4; ++o) l4[o] = gi == 0 ? lg[4 + o] : gi == 1 ? lg[8 + o] : gi == 2 ? lg[12 + o] : lg[16 + o];
            int e0 = 0; float v0 = l4[0];
#pragma unroll
            for (int o = 1; o < 4; ++o) if (l4[o] > v0) { e0 = o; v0 = l4[o]; }
            int e1 = -1; float v1 = -INFINITY;
#pragma unroll
            for (int o = 0; o < 4; ++o) if (o != e0 && (e1 < 0 || l4[o] > v1)) { e1 = o; v1 = l4[o]; }
            const float p1 = __expf(v1 - v0), w0 = gp / (1.f + p1), w1 = gp * p1 / (1.f + p1);
            if (lane == 0) { const unsigned E0 = gi * 4 + e0, E1 = gi * 4 + e1;
                const unsigned q0 = atomicAdd((unsigned*)&lcnt[E0], 1u), q1 = atomicAdd((unsigned*)&lcnt[E1], 1u);
                dec[rl * 6 + 0] = E0; dec[rl * 6 + 1] = E1; dec[rl * 6 + 2] = q0; dec[rl * 6 + 3] = q1; dec[rl * 6 + 4] = __float_as_uint(w0); dec[rl * 6 + 5] = __float_as_uint(w1); }
        }
        __syncthreads();
        if (tid < 16) lbase[tid] = __hip_atomic_fetch_add(gcnt + tid, lcnt[tid], RLX_AGENT);
        __syncthreads();
        if (tid < 128) { const int t = rb * 128 + tid; const unsigned E0 = dec[tid * 6], E1 = dec[tid * 6 + 1], p0 = lbase[E0] + dec[tid * 6 + 2], p1 = lbase[E1] + dec[tid * 6 + 3];
            LIST[(size_t)E0 * T + p0] = t; LIST[(size_t)E1 * T + p1] = t; TOK[t] = make_uint4((E0 << 24) | p0, (E1 << 24) | p1, dec[tid * 6 + 4], dec[tid * 6 + 5]); }
        __syncthreads();
    }
}
__device__ __forceinline__ void moe_tile_bases(Frame& F, const gu32* gcnt) {
    LAS unsigned* TB = (LAS unsigned*)(F.lds + TAB_TB);
    if (F.tid == 0) { unsigned acc = 0u; for (int e = 0; e < 16; ++e) { TB[e] = acc; const unsigned c = __hip_atomic_load(gcnt + e, RLX_AGENT); TB[32 + e] = c; acc += (c + 255u) >> 8; } TB[16] = acc; }
    __syncthreads();
}
__device__ __forceinline__ void p8_combine_ln(Frame& F, const bf16* X1, const bf16* Y, const uint4* TOK, const float* g, const float* bb, bf16* XBo, float* outf) {
    const LAS unsigned* TB = (const LAS unsigned*)(F.lds + TAB_TB); const int lane = F.lane;
    float gg[16], gb[16];
#pragma unroll
    for (int j = 0; j < 2; ++j)
#pragma unroll
        for (int q = 0; q < 2; ++q) { const f32x4 a = *(const f32x4*)(g + j * 512 + lane * 8 + q * 4), c = *(const f32x4*)(bb + j * 512 + lane * 8 + q * 4);
#pragma unroll
            for (int e = 0; e < 4; ++e) { gg[j * 8 + q * 4 + e] = a[e]; gb[j * 8 + q * 4 + e] = c[e]; } }
    const int gw = F.vcu * NWAVES + F.wave, NGW = F.G * NWAVES;
    for (int t = gw; t < T; t += NGW) {
        const uint4 ti = TOK[t]; const size_t s0 = (size_t)TB[ti.x >> 24] * 256 + (ti.x & 0xffffffu), s1 = (size_t)TB[ti.y >> 24] * 256 + (ti.y & 0xffffffu);
        const float w0 = __uint_as_float(ti.z), w1 = __uint_as_float(ti.w);
        float v[16]; float s = 0.f;
#pragma unroll
        for (int j = 0; j < 2; ++j) { const u32x4 a = *(const u32x4*)(X1 + (size_t)t * D + j * 512 + lane * 8), y0 = *(const u32x4*)(Y + s0 * D + j * 512 + lane * 8), y1 = *(const u32x4*)(Y + s1 * D + j * 512 + lane * 8);
#pragma unroll
            for (int e = 0; e < 4; ++e) { v[j * 8 + 2 * e] = ALPHA * __uint_as_float(a[e] << 16) + w0 * __uint_as_float(y0[e] << 16) + w1 * __uint_as_float(y1[e] << 16);
                v[j * 8 + 2 * e + 1] = ALPHA * __uint_as_float(a[e] & 0xffff0000u) + w0 * __uint_as_float(y0[e] & 0xffff0000u) + w1 * __uint_as_float(y1[e] & 0xffff0000u); } }
#pragma unroll
        for (int e = 0; e < 16; ++e) s += v[e];
        const float mu = wave_sum(s) * (1.f / 1024.f); float q = 0.f;
#pragma unroll
        for (int e = 0; e < 16; ++e) { v[e] -= mu; q += v[e] * v[e]; }
        const float rstd = rsqrtf(wave_sum(q) * (1.f / 1024.f) + LN_EPS);
#pragma unroll
        for (int e = 0; e < 16; ++e) v[e] = v[e] * rstd * gg[e] + gb[e];
        if (outf) {
#pragma unroll
            for (int j = 0; j < 2; ++j)
#pragma unroll
                for (int q2 = 0; q2 < 2; ++q2) *(f32x4*)(outf + (size_t)t * D + j * 512 + lane * 8 + q2 * 4) = (f32x4){v[j * 8 + q2 * 4], v[j * 8 + q2 * 4 + 1], v[j * 8 + q2 * 4 + 2], v[j * 8 + q2 * 4 + 3]};
        } else {
#pragma unroll
            for (int j = 0; j < 2; ++j) *(u32x4*)(XBo + (size_t)t * D + j * 512 + lane * 8) = (u32x4){pk2(v[j * 8], v[j * 8 + 1]), pk2(v[j * 8 + 2], v[j * 8 + 3]), pk2(v[j * 8 + 4], v[j * 8 + 5]), pk2(v[j * 8 + 6], v[j * 8 + 7])};
        }
    }
}
constexpr int N_PHASES = 17;
__global__ void __launch_bounds__(NWAVES * 64, 2) mega_fwd(Args args) {
    extern __shared__ __attribute__((aligned(16))) unsigned char lds[];
    Frame F;
    F.lds = (LAS unsigned char*)lds; F.lds_gen = lds;
    F.MISC = (volatile LAS unsigned*)(F.lds + MISC_OFF);
    F.tid = threadIdx.x; F.lane = F.tid & 63; F.wave = __builtin_amdgcn_readfirstlane(F.tid >> 6);
    F.G = gridDim.x; { const int bx = blockIdx.x; F.vcu = (F.G % 8 == 0) ? (bx % 8) * (F.G / 8) + bx / 8 : bx; }
    F.ctl = (gu32*)(args.ws + WS_CTL);
    for (int u = F.tid; u < (LDS_BYTES - LDSCTL_OFF) / 4; u += NWAVES * 64) ((LAS unsigned*)(F.lds + LDSCTL_OFF))[u] = 0u;
    __syncthreads();
    const int lo = args.ph_lo, hi = args.ph_hi;
    const bool multi = (hi - lo) > 1;
    XcdBarrier bar; bar.bar = (unsigned*)(F.ctl + CW_BAR); bar.x = 0; bar.st = nullptr;
    if (multi) bar = xcd_barrier_post((unsigned*)(F.ctl + CW_BAR), F.MISC + 8);
#ifndef MK_CM
#define MK_CM 0x1FF
#endif
#define IN(k) (lo <= (k) && (k) < hi)
#define INK(r) (((MK_CM >> ((r) + 1)) & 1) && IN(p + (r)))
#define SEAM(k) do { if (IN((k) + 1)) xcd_barrier(bar); } while (0)
#define PHASE_BEGIN() const __attribute__((address_space(4))) Args* ka; { const __attribute__((address_space(4))) Args* k_ = (const __attribute__((address_space(4))) Args*)__builtin_amdgcn_kernarg_segment_ptr(); asm volatile("" : "+s"(k_)); ka = k_; } \
    unsigned char* const ws = ka->ws; { int t_ = threadIdx.x; asm volatile("" : "+v"(t_)); F.tid = t_; F.lane = t_ & 63; F.wave = __builtin_amdgcn_readfirstlane(t_ >> 6); } \
    int bx; { int b_ = blockIdx.x; asm volatile("" : "+s"(b_)); bx = b_; F.vcu = (F.G % 8 == 0) ? (bx % 8) * (F.G / 8) + bx / 8 : bx; } (void)bx; \
    bf16* const XB = (bf16*)(ws + WS_XB); bf16* const PROJ = (bf16*)(ws + WS_PROJ); bf16* const MIX = (bf16*)(ws + WS_MIX); bf16* const PRE = (bf16*)(ws + WS_PRE); \
    bf16* const X1 = (bf16*)(ws + WS_X1); bf16* const Hb = (bf16*)(ws + WS_H); bf16* const Yb = (bf16*)(ws + WS_Y); bf16* const KM = (bf16*)(ws + WS_KM); \
    float* const SSQ = (float*)(ws + WS_SSQ); uint4* const TOK = (uint4*)(ws + WS_TOK); int* const LIST = (int*)(ws + WS_LIST); float2* const SUMM = (float2*)(ws + WS_SUMM); \
    (void)XB; (void)PROJ; (void)MIX; (void)PRE; (void)X1; (void)Hb; (void)Yb; (void)KM; (void)SSQ; (void)TOK; (void)LIST; (void)SUMM;

    if ((MK_CM & 1) && IN(0)) { PHASE_BEGIN(); p0_prologue(F, ka); SEAM(0); }

#pragma nounroll
    for (int l = 0; l < 2; ++l) {
        const int p = 1 + 8 * l;
        if (INK(0)) { PHASE_BEGIN();
            DenseOrder S; S.init(XB, (const bf16*)(ws + WS_WIN) + (size_t)l * NPROJ * D, T, NPROJ, D, F.G, bx);
            EpiProj E{PROJ, (const float2*)(ws + WS_ROPE)};
            gemm_phase<EpiProj, DenseOrder, false, false>(F.lds + RING_OFF, D, S, E, nullptr);
            SEAM(p);
        }
        if (INK(1)) { PHASE_BEGIN();
            if (!(args.skip & 1)) for (int it = F.vcu; it < NB * NBLK; it += F.G) kmean_item(F, it, PROJ, KM);
            if (!(args.skip & 2)) for (int it = F.vcu; it < NB * 16 * 8; it += F.G) { const int n = it & 7, ck = (it >> 3) & 15, b = it >> 7;
                rglru_unit<false>(F, b, ck, n, PROJ, ka->in[2] + l * 2048, ka->in[3] + l * 512, (const bf16*)(ws + WS_WRG) + (size_t)l * 65536, ka->in[5] + l * 512, ka->in[7] + l * 512, (const float*)(ws + WS_SP) + l * 512, SUMM, MIX, SSQ); }
            SEAM(p + 1);
        }
        if (INK(2)) { PHASE_BEGIN();
            if (!((MK_CM >> 9) & 1) && !(args.skip & 4)) { const attn_body::AttnTensors AT{PROJ + QOFF, PROJ + KOFF, PROJ + VOFF, MIX, KM, SSQ};
                const attn_body::StaticOrder S((int)F.G, bx);
                attn_body::attn_phase<attn_body::StaticOrder>((char*)lds + RING_OFF, AT, S); }
            if (!((MK_CM >> 10) & 1) && !(args.skip & 8)) for (int it = F.vcu; it < NB * 16 * 8; it += F.G) { const int n = it & 7, ck = (it >> 3) & 15, b = it >> 7;
                rglru_unit<true>(F, b, ck, n, PROJ, ka->in[2] + l * 2048, ka->in[3] + l * 512, (const bf16*)(ws + WS_WRG) + (size_t)l * 65536, ka->in[5] + l * 512, ka->in[7] + l * 512, (const float*)(ws + WS_SP) + l * 512, SUMM, MIX, SSQ); }
            SEAM(p + 2);
        }
        if (INK(3)) { PHASE_BEGIN();
            DenseOrder S; S.init(MIX, (const bf16*)(ws + WS_WOUT) + (size_t)l * D * D, T, D, D, F.G, bx);
            EpiOut E{PRE, XB, SSQ, (LAS f32x2*)(F.lds + TAB_RS)};
            gemm_phase<EpiOut, DenseOrder, false, true>(F.lds + RING_OFF, D, S, E, nullptr);
            SEAM(p + 3);
        }
        if (INK(4)) { PHASE_BEGIN();
            p5_ln_router(F, PRE, ka->in[12] + l * D, ka->in[13] + l * D, X1, ka->in[14] + l * 4096, ka->in[15] + l * 4, ka->in[16] + l * 16384, ka->in[17] + l * 16, F.ctl + CW_CNT + 64 * l, LIST, TOK);
            SEAM(p + 4);
        }
        if (INK(5)) { PHASE_BEGIN();
            moe_tile_bases(F, F.ctl + CW_CNT + 64 * l);
            const LAS unsigned* TB = (const LAS unsigned*)(F.lds + TAB_TB); LAS unsigned* GI = (LAS unsigned*)(F.lds + TAB_GIDX);
            MoeOrder S{TB, F.G, bx, (const char*)X1, (const char*)((const bf16*)(ws + WS_WGU) + (size_t)l * 16 * 1024 * D), 0, (size_t)1024 * D * 2, (size_t)256 * D * 2, 128, true};
            { Unit u; for (int i = 0; i < 6 && S.next(i, u); ++i) { if (F.tid < 256) { const int mtg = u.orow >> 8; int e = 0;
#pragma unroll
                        for (int j = 1; j < 16; ++j) e += ((int)TB[j] <= mtg) ? 1 : 0;
                        const int pos = (mtg - (int)TB[e]) * 256 + F.tid; const int cn = (int)TB[32 + e];
                        GI[i * 256 + F.tid] = (unsigned)LIST[(size_t)e * T + (pos < cn ? pos : 0)]; } } }
            __syncthreads();
            EpiSwiglu E{Hb};
            gemm_phase<EpiSwiglu, MoeOrder, true, false>(F.lds + RING_OFF, D, S, E, GI);
            SEAM(p + 5);
        }
        if (INK(6)) { PHASE_BEGIN();
            moe_tile_bases(F, F.ctl + CW_CNT + 64 * l);
            const LAS unsigned* TB = (const LAS unsigned*)(F.lds + TAB_TB);
            MoeOrder S{TB, F.G, bx, (const char*)Hb, (const char*)((const bf16*)(ws + WS_WD) + (size_t)l * 16 * D * DEXP), (size_t)256 * DEXP * 2, (size_t)D * DEXP * 2, (size_t)256 * DEXP * 2, 256, false};
            EpiPlain E{Yb, D};
            gemm_phase<EpiPlain, MoeOrder, false, false>(F.lds + RING_OFF, DEXP, S, E, nullptr);
            SEAM(p + 6);
        }
        if (INK(7)) { PHASE_BEGIN();
            moe_tile_bases(F, F.ctl + CW_CNT + 64 * l);
            p8_combine_ln(F, X1, Yb, TOK, ka->in[21] + l * D, ka->in[22] + l * D, XB, l == 1 ? ka->out : nullptr);
            if (l == 0) SEAM(p + 7);
        }
    }
#undef IN
#undef PHASE_BEGIN
#undef INK
#undef SEAM
}
}
#ifndef MK_IMPL
#define MK_IMPL 0x1FFFF
#endif
#ifndef MK_PARTS
#define MK_PARTS 7
#endif
#ifndef MK_FUSE
#define MK_FUSE 1
#endif
struct Ptrs { const float* in[23]; };
static void nb_phase(int ph, const Ptrs& P, float* d_out, unsigned char* ws, hipStream_t st, int parts) {
    using namespace cfg;
    bf16* XB = (bf16*)(ws + WS_XB); bf16* PROJ = (bf16*)(ws + WS_PROJ); bf16* MIX = (bf16*)(ws + WS_MIX); bf16* PRE = (bf16*)(ws + WS_PRE);
    bf16* X1 = (bf16*)(ws + WS_X1); bf16* Hb = (bf16*)(ws + WS_H); bf16* Yb = (bf16*)(ws + WS_Y); bf16* KM = (bf16*)(ws + WS_KM);
    float* SSQ = (float*)(ws + WS_SSQ); uint4* TOK = (uint4*)(ws + WS_TOK); int* LIST = (int*)(ws + WS_LIST); unsigned* CTL = (unsigned*)(ws + WS_CTL);
    if (ph == 0) { nb::x_to_bf16<<<(T * D / 4 + 255) / 256, 256, 0, st>>>(P.in[0], XB); return; }
    const int l = (ph - 1) / 8, k = (ph - 1) % 8; unsigned* cnt = CTL + CW_CNT + 64 * l;
    switch (k) {
    case 0: nb::gemm<0><<<dim3(NPROJ / 64, T / 64), 256, 0, st>>>(XB, D, nullptr, nullptr, 0, T, P.in[1] + (size_t)l * D * NPROJ, nullptr, NPROJ, PROJ, NPROJ, D, nullptr, nullptr, nullptr, nullptr);
            nb::rope_scale<<<(T * 1024) / 256, 256, 0, st>>>(PROJ); break;
    case 1: if (!(parts & 1)) nb::kmean<<<(NB * NH * NBLK * HD) / 256, 256, 0, st>>>(PROJ, KM); break;
    case 2: { if (!(parts & 4)) nb::attn<<<T * NH, 64, 0, st>>>(PROJ, KM, MIX);
            if (!(parts & 2)) { float* Aa = d_out; float* U = d_out + (size_t)T * 512;
                nb::rglru_gates<<<T * 8, 64, 0, st>>>(PROJ, P.in[2] + l * 2048, P.in[3] + l * 512, P.in[4] + l * 32768, P.in[5] + l * 512, P.in[6] + l * 32768, P.in[7] + l * 512, P.in[8] + l * 512, Aa, U);
                nb::rglru_scan<<<(NB * 512) / 256, 256, 0, st>>>(Aa, U, PROJ, MIX); }
            if ((parts & 6) != 6) nb::ssq_groups<<<(T * 16) / 256, 256, 0, st>>>(MIX, SSQ); } break;
    case 3: nb::gemm<3><<<dim3(D / 64, T / 64), 256, 0, st>>>(MIX, D, nullptr, nullptr, 0, T, P.in[11] + (size_t)l * D * D, nullptr, D, PRE, D, D, SSQ, P.in[9] + l * 512, P.in[10] + l * 512, XB); break;
    case 4: nb::ln_router<<<T / 4, 256, 0, st>>>(PRE, P.in[12] + l * D, P.in[13] + l * D, X1, P.in[14] + l * 4096, P.in[15] + l * 4, P.in[16] + l * 16384, P.in[17] + l * 16, cnt, LIST, TOK); break;
    case 5: for (int e = 0; e < 16; ++e) nb::gemm<1><<<dim3(512 / 64, T / 64), 256, 0, st>>>(X1, D, LIST, cnt, e, T, P.in[18] + ((size_t)l * 16 + e) * D * 512, P.in[19] + ((size_t)l * 16 + e) * D * 512, 512, Hb, 512, D, nullptr, nullptr, nullptr, nullptr); break;
    case 6: for (int e = 0; e < 16; ++e) nb::gemm<0><<<dim3(D / 64, T / 64), 256, 0, st>>>(Hb, 512, nullptr, cnt, e, T, P.in[20] + ((size_t)l * 16 + e) * 512 * D, nullptr, D, Yb, D, 512, nullptr, nullptr, nullptr, nullptr); break;
    case 7: nb::combine_ln<<<T / 4, 256, 0, st>>>(X1, Yb, TOK, cnt, P.in[21] + l * D, P.in[22] + l * D, XB, l == 1 ? d_out : nullptr); break;
    }
}
extern "C" void kernel_launch(void* const* d_in, const int* in_sizes, int n_in, void* d_out, int out_size, void* d_ws, size_t ws_size, hipStream_t stream) {
    static int grid = 0;
    if (grid == 0) {
        if (n_in != 23 || in_sizes[0] != cfg::T * cfg::D || out_size != cfg::T * cfg::D || ws_size < cfg::WS_END) { fprintf(stderr, "kernel_launch: unexpected problem (n_in %d, ws %zu)\n", n_in, ws_size); grid = -1; return; }
        int dev = 0, cus = 0, per_cu = 0;
        if (hipGetDevice(&dev) != hipSuccess || hipDeviceGetAttribute(&cus, hipDeviceAttributeMultiprocessorCount, dev) != hipSuccess) { grid = -1; return; }
        if (hipFuncSetAttribute((const void*)mk::mega_fwd, hipFuncAttributeMaxDynamicSharedMemorySize, mk::LDS_BYTES) != hipSuccess) { fprintf(stderr, "kernel_launch: hipFuncSetAttribute failed\n"); grid = -1; return; }
        if (hipOccupancyMaxActiveBlocksPerMultiprocessor(&per_cu, (const void*)mk::mega_fwd, mk::NWAVES * 64, mk::LDS_BYTES) != hipSuccess || per_cu < 1) { fprintf(stderr, "kernel_launch: occupancy query says %d blocks per CU\n", per_cu); }
        (void)hipGetLastError();
        grid = cus;
    }
    if (grid < 0) return;
    Ptrs P; for (int i = 0; i < 23; ++i) P.in[i] = (const float*)d_in[i];
    unsigned char* ws = (unsigned char*)d_ws;
    (void)hipMemsetAsync(ws + cfg::WS_CTL, 0, cfg::CTL_ZERO_BYTES, stream);
    mk::Args a{}; for (int i = 0; i < 23; ++i) a.in[i] = P.in[i]; a.out = (float*)d_out; a.ws = ws; a.skip = (~MK_PARTS) & 7; a.skip = (a.skip & 1) | ((a.skip & 2) ? (2 | 8) : 0) | ((a.skip & 4) ? 4 : 0); a.pad = 0;
    int i = 0;
    while (i < mk::N_PHASES) {
        const bool mega = (MK_IMPL >> i) & 1;
        const int k = (i - 1) % 8;
        if (!mega) { nb_phase(i, P, (float*)d_out, ws, stream, 0); ++i; continue; }
        int j = i + 1;
        const bool mixed_here = (i > 0) && (k == 1 || k == 2) && (MK_PARTS != 7);
        if (MK_FUSE && !mixed_here) while (j < mk::N_PHASES && ((MK_IMPL >> j) & 1) && !(((j - 1) % 8 == 1 || (j - 1) % 8 == 2) && MK_PARTS != 7)) ++j;
        a.ph_lo = i; a.ph_hi = j;
        if (!(mixed_here && MK_PARTS == 0)) hipLaunchKernelGGL(mk::mega_fwd, dim3(grid), dim3(mk::NWAVES * 64), mk::LDS_BYTES, stream, a);
        if (mixed_here) nb_phase(i, P, (float*)d_out, ws, stream, MK_PARTS);
        i = j;
    }
}
```

```cpp
#include <hip/hip_runtime.h>
#include <cstdio>
#include <cstdint>
#include <cmath>

namespace cfg {
constexpr int NB = 8, NS = 4096, D = 1024, T = NB * NS, NPROJ = 2560, NH = 8, HD = 64, NBLK = 16, NEXP = 16, DEXP = 512;
constexpr int QOFF = 0, KOFF = 512, VOFF = 1024, XROFF = 1536, GROFF = 2048;
constexpr float ALPHA = 1.41421356237309515f;
constexpr float C2 = 0.125f * 1.4426950408889634f;
constexpr float LN_EPS = 1e-5f, RMS_EPS = 1e-6f;
constexpr size_t MiB = 1u << 20;
constexpr size_t WS_CTL = 0, CTL_ZERO_BYTES = 1 * MiB;
constexpr size_t WS_WIN = 2 * MiB;
constexpr size_t WS_WOUT = 12 * MiB;
constexpr size_t WS_WGU = 16 * MiB;
constexpr size_t WS_WD = 80 * MiB;
constexpr size_t WS_SMALL = 112 * MiB;
constexpr size_t WS_ROPE = WS_SMALL;
constexpr size_t WS_KM = WS_SMALL + 1 * MiB;
constexpr size_t WS_SUMM = WS_SMALL + 2 * MiB;
constexpr size_t WS_WRG = WS_SMALL + 3 * MiB;
constexpr size_t WS_SP = WS_SMALL + 3 * MiB + 512 * 1024;
constexpr size_t WS_SSQ = WS_SMALL + 4 * MiB;
constexpr size_t WS_TOK = WS_SMALL + 6 * MiB;
constexpr size_t WS_LIST = WS_SMALL + 8 * MiB;
constexpr size_t WS_XB = 128 * MiB;
constexpr size_t WS_PROJ = 192 * MiB;
constexpr size_t WS_MIX = 352 * MiB;
constexpr size_t WS_PRE = 416 * MiB;
constexpr size_t WS_X1 = 192 * MiB;
constexpr size_t WS_H = 256 * MiB;
constexpr size_t WS_Y = 324 * MiB;
constexpr size_t WS_END = 480 * MiB;
constexpr int MAXSLOT = 69632;
constexpr int CW_TMO = 0, CW_CODE = 1, CW_BAR = 4096, CW_CNT = 8192;
}

typedef unsigned short bf16;
__device__ __forceinline__ float bf2f(bf16 v) { return __uint_as_float((unsigned)v << 16); }
__device__ __forceinline__ unsigned f2bf(float f) { unsigned u = __builtin_bit_cast(unsigned, f); return (u + 0x7fffu + ((u >> 16) & 1u)) >> 16; }
__device__ __forceinline__ unsigned pk2(float lo, float hi) { return f2bf(lo) | (f2bf(hi) << 16); }
__device__ __forceinline__ float gelu_tanh_f(float x) { const float y = 0.7978845608028654f * (x + 0.044715f * x * x * x); return x / (1.f + __expf(-2.f * y)); }
#define MK_IMPL 0x1FFFF
#define MK_PARTS 7
#define MK_FUSE 1
#define MK_REPEAT 0
#define MK_RSKIP 0
namespace nb {
using namespace cfg;
__device__ __forceinline__ float wsum(float v) { for (int o = 32; o; o >>= 1) v += __shfl_xor(v, o); return v; }
__device__ __forceinline__ float wmax(float v) { for (int o = 32; o; o >>= 1) v = fmaxf(v, __shfl_xor(v, o)); return v; }

__global__ void x_to_bf16(const float* __restrict__ x, bf16* __restrict__ xb) {
    const size_t i = ((size_t)blockIdx.x * blockDim.x + threadIdx.x) * 4; if (i >= (size_t)T * D) return;
    const float4 v = *(const float4*)(x + i); *(uint2*)(xb + i) = make_uint2(pk2(v.x, v.y), pk2(v.z, v.w));
}
template <int MODE>
__global__ __launch_bounds__(256) void gemm(const bf16* __restrict__ A, int lda, const int* __restrict__ list, const unsigned* __restrict__ cnt, int e, int Mmax,
                                            const float* __restrict__ B0, const float* __restrict__ B1, int ldb, bf16* C, int ldc, int K,
                                            const float* __restrict__ ssq, const float* __restrict__ ga, const float* __restrict__ gr, const bf16* __restrict__ res) {
    int M = Mmax, obase = 0;
    if (cnt) { M = (int)cnt[e]; for (int j = 0; j < e; ++j) obase += (((int)cnt[j] + 255) >> 8) << 8; }
    const int m0 = blockIdx.y * 64, n0 = blockIdx.x * 64;
    if (m0 >= M) return;
    __shared__ float As[16][65];
    __shared__ float Bs[16][64];
    __shared__ float Bs1[MODE == 1 ? 16 : 1][64];
    const int tid = threadIdx.x, tx = tid & 15, ty = tid >> 4;
    float acc[4][4] = {}, acc1[4][4] = {};
    const int ar = tid >> 2, ak = (tid & 3) * 4;
    const int arow = m0 + ar; const bool avalid = arow < M;
    const int srow = avalid ? (list ? list[(size_t)e * T + arow] : (cnt ? obase + arow : arow)) : 0;
    float sa = 1.f, sr = 1.f;
    if (MODE == 3) { float a = 0.f, r = 0.f; for (int j = 0; j < 8; ++j) { a += ssq[(size_t)srow * 16 + j]; r += ssq[(size_t)srow * 16 + 8 + j]; } sa = rsqrtf(a * (1.f / 512.f) + RMS_EPS); sr = rsqrtf(r * (1.f / 512.f) + RMS_EPS); }
    const int bk = tid >> 4, bn = (tid & 15) * 4;
    for (int k0 = 0; k0 < K; k0 += 16) {
        float av[4] = {0.f, 0.f, 0.f, 0.f};
        if (avalid) { const uint2 raw = *(const uint2*)(A + (size_t)srow * lda + k0 + ak);
            av[0] = bf2f((bf16)(raw.x & 0xffff)); av[1] = bf2f((bf16)(raw.x >> 16)); av[2] = bf2f((bf16)(raw.y & 0xffff)); av[3] = bf2f((bf16)(raw.y >> 16));
            if (MODE == 3) { for (int j = 0; j < 4; ++j) { const int k = k0 + ak + j; av[j] *= (k < 512) ? sa * ga[k] : sr * gr[k - 512]; } } }
        As[ak + 0][ar] = av[0]; As[ak + 1][ar] = av[1]; As[ak + 2][ar] = av[2]; As[ak + 3][ar] = av[3];
        *(float4*)&Bs[bk][bn] = *(const float4*)(B0 + (size_t)(k0 + bk) * ldb + n0 + bn);
        if (MODE == 1) *(float4*)&Bs1[bk][bn] = *(const float4*)(B1 + (size_t)(k0 + bk) * ldb + n0 + bn);
        __syncthreads();
#pragma unroll
        for (int k = 0; k < 16; ++k) {
            float a[4], b[4], b1[4];
#pragma unroll
            for (int j = 0; j < 4; ++j) { a[j] = As[k][ty * 4 + j]; b[j] = Bs[k][tx * 4 + j]; if (MODE == 1) b1[j] = Bs1[k][tx * 4 + j]; }
#pragma unroll
            for (int j = 0; j < 4; ++j)
#pragma unroll
                for (int l = 0; l < 4; ++l) { acc[j][l] += a[j] * b[l]; if (MODE == 1) acc1[j][l] += a[j] * b1[l]; }
        }
        __syncthreads();
    }
#pragma unroll
    for (int j = 0; j < 4; ++j) {
        const int r = m0 + ty * 4 + j; if (r >= M) continue;
        float o[4];
#pragma unroll
        for (int l = 0; l < 4; ++l) { o[l] = acc[j][l]; if (MODE == 1) { const float g = acc[j][l]; o[l] = g / (1.f + __expf(-g)) * acc1[j][l]; }
            if (MODE == 3) o[l] = ALPHA * bf2f(res[(size_t)r * ldc + n0 + tx * 4 + l]) + acc[j][l]; }
        *(uint2*)(C + (size_t)(obase + r) * ldc + n0 + tx * 4) = make_uint2(pk2(o[0], o[1]), pk2(o[2], o[3]));
    }
}
__global__ void rope_scale(bf16* proj) {
    const size_t i = (size_t)blockIdx.x * blockDim.x + threadIdx.x; if (i >= (size_t)T * 1024) return;
    const int c = (int)(i & 1023); const size_t t = i >> 10; const int d = c & 63, s = (int)(t % NS);
    bf16* p = proj + t * NPROJ + c; const float sc = c < 512 ? C2 : 1.f;
    if (d >= 16) { if (c < 512) *p = (bf16)f2bf(bf2f(*p) * sc); return; }
    if (d >= 8) return;
    const float inv = powf(500000.0f, -(float)d / 8.0f), ang = (float)s * inv, cs = cosf(ang), sn = sinf(ang);
    const float a = bf2f(p[0]), b = bf2f(p[8]);
    p[0] = (bf16)f2bf((a * cs - b * sn) * sc); p[8] = (bf16)f2bf((b * cs + a * sn) * sc);
}
__global__ void kmean(const bf16* __restrict__ proj, bf16* __restrict__ km) {
    const int i = blockIdx.x * blockDim.x + threadIdx.x; if (i >= NB * NH * NBLK * HD) return;
    const int d = i & 63, blk = (i >> 6) & 15, h = (i >> 10) & 7, b = i >> 13; float s = 0.f;
    for (int r = 0; r < 256; ++r) s += bf2f(proj[((size_t)b * NS + blk * 256 + r) * NPROJ + KOFF + h * 64 + d]);
    km[i] = (bf16)f2bf(s * (1.f / 256.f));
}
__global__ __launch_bounds__(64) void attn(const bf16* __restrict__ proj, const bf16* __restrict__ km, bf16* __restrict__ mix) {
    const int idx = blockIdx.x, h = idx & 7; const int t = idx >> 3, b = t / NS, s = t % NS, bi = s >> 8, lane = threadIdx.x;
    __shared__ float qs[64]; __shared__ float ps[1024]; __shared__ int sel[3]; __shared__ float gate[16];
    qs[lane] = bf2f(proj[(size_t)t * NPROJ + h * 64 + lane]);
    __syncthreads();
    if (lane < 16) { float g = -INFINITY;
        if (lane < bi) { g = 0.f; const bf16* kp = km + ((b * NH + h) * NBLK + lane) * 64; for (int d = 0; d < 64; ++d) g += qs[d] * bf2f(kp[d]); }
        gate[lane] = g; }
    __syncthreads();
    if (lane == 0) { unsigned used = 0u;
        for (int r = 0; r < 3; ++r) { int best = -1; float bv = -INFINITY;
            for (int j = 0; j < 16; ++j) if (!((used >> j) & 1u) && (best < 0 || gate[j] > bv)) { best = j; bv = gate[j]; }
            used |= 1u << best; sel[r] = best; } }
    __syncthreads();
    const int nblk = bi < 3 ? bi : 3; float mx = -INFINITY;
    for (int j = 0; j < 4; ++j) { const int blk = (j < 3) ? sel[j] : bi; const bool valid = (j < 3) ? (j < nblk) : true;
        for (int i = 0; i < 4; ++i) { const int key = blk * 256 + i * 64 + lane; float sc = -INFINITY;
            if (valid && !(j == 3 && key > s)) { const bf16* kp = proj + ((size_t)b * NS + key) * NPROJ + KOFF + h * 64; float a = 0.f; for (int d = 0; d < 64; ++d) a += qs[d] * bf2f(kp[d]); sc = a; }
            ps[j * 256 + i * 64 + lane] = sc; mx = fmaxf(mx, sc); } }
    mx = wmax(mx); float sum = 0.f;
    for (int e2 = lane; e2 < 1024; e2 += 64) { const float p = (ps[e2] == -INFINITY) ? 0.f : exp2f(ps[e2] - mx); ps[e2] = p; sum += p; }
    sum = wsum(sum);
    __syncthreads();
    const float inv = 1.f / sum; float acc = 0.f;
    for (int j = 0; j < 4; ++j) { const int blk = (j < 3) ? sel[j] : bi; const bool valid = (j < 3) ? (j < nblk) : true; if (!valid) continue;
        for (int i = 0; i < 256; ++i) { const float p = ps[j * 256 + i]; if (p != 0.f) acc += p * bf2f(proj[((size_t)b * NS + blk * 256 + i) * NPROJ + VOFF + h * 64 + lane]); } }
    mix[(size_t)t * D + h * 64 + lane] = (bf16)f2bf(acc * inv);
}
__global__ __launch_bounds__(64) void rglru_gates(const bf16* __restrict__ proj, const float* __restrict__ conv_w, const float* __restrict__ conv_b,
                                                  const float* __restrict__ w_a, const float* __restrict__ b_a, const float* __restrict__ w_i, const float* __restrict__ b_i,
                                                  const float* __restrict__ lam, float* __restrict__ Aout, float* __restrict__ Uout) {
    const int n = blockIdx.x & 7; const size_t t = blockIdx.x >> 3; const int c = threadIdx.x, ch = n * 64 + c, s = (int)(t % NS);
    float xc = conv_b[ch];
    for (int w = 0; w < 4; ++w) { const int sp = s - 3 + w; if (sp >= 0) xc += conv_w[w * 512 + ch] * bf2f(proj[(t - 3 + w) * NPROJ + XROFF + ch]); }
    __shared__ float xs[64]; xs[c] = xc; __syncthreads();
    float ra = b_a[ch], ri = b_i[ch];
    for (int cc = 0; cc < 64; ++cc) { ra += xs[cc] * w_a[(n * 64 + cc) * 64 + c]; ri += xs[cc] * w_i[(n * 64 + cc) * 64 + c]; }
    const float r = 1.f / (1.f + expf(-ra)), ig = 1.f / (1.f + expf(-ri));
    const float la = -8.0f * r * log1pf(expf(-lam[ch]));
    Aout[t * 512 + ch] = expf(la); Uout[t * 512 + ch] = sqrtf(-expm1f(2.f * la)) * (ig * xc);
}
__global__ void rglru_scan(const float* __restrict__ Aa, const float* __restrict__ U, const bf16* __restrict__ proj, bf16* __restrict__ mix) {
    const int i = blockIdx.x * blockDim.x + threadIdx.x; if (i >= NB * 512) return;
    const int b = i >> 9, ch = i & 511; float h = 0.f;
    for (int s0 = 0; s0 < NS; s0 += 8) {
        float a[8], u[8], g[8];
#pragma unroll
        for (int j = 0; j < 8; ++j) { const size_t t = (size_t)b * NS + s0 + j; a[j] = Aa[t * 512 + ch]; u[j] = U[t * 512 + ch]; g[j] = bf2f(proj[t * NPROJ + GROFF + ch]); }
#pragma unroll
        for (int j = 0; j < 8; ++j) { const size_t t = (size_t)b * NS + s0 + j; h = a[j] * h + u[j]; mix[t * D + 512 + ch] = (bf16)f2bf(h * gelu_tanh_f(g[j])); }
    }
}
__global__ void ssq_groups(const bf16* __restrict__ mix, float* __restrict__ ssq) {
    const size_t i = (size_t)blockIdx.x * blockDim.x + threadIdx.x; if (i >= (size_t)T * 16) return;
    const bf16* p = mix + (i >> 4) * D + (i & 15) * 64; float s = 0.f; for (int j = 0; j < 64; ++j) { const float v = bf2f(p[j]); s += v * v; } ssq[i] = s;
}
__global__ __launch_bounds__(256) void ln_router(const bf16* __restrict__ pre, const float* __restrict__ g, const float* __restrict__ bb, bf16* __restrict__ x1,
                                                 const float* __restrict__ wg, const float* __restrict__ bg, const float* __restrict__ we, const float* __restrict__ be,
                                                 unsigned* cnt, int* list, uint4* tokinfo) {
    const int t = blockIdx.x * 4 + (threadIdx.x >> 6), lane = threadIdx.x & 63;
    float v[16], s = 0.f;
#pragma unroll
    for (int j = 0; j < 16; ++j) { v[j] = bf2f(pre[(size_t)t * D + j * 64 + lane]); s += v[j]; }
    const float mu = wsum(s) * (1.f / 1024.f); float q = 0.f;
#pragma unroll
    for (int j = 0; j < 16; ++j) { v[j] -= mu; q += v[j] * v[j]; }
    const float rstd = rsqrtf(wsum(q) * (1.f / 1024.f) + LN_EPS);
    float lg[4] = {}, le[16] = {};
#pragma unroll
    for (int j = 0; j < 16; ++j) { const int c = j * 64 + lane; const float xv = v[j] * rstd * g[c] + bb[c]; x1[(size_t)t * D + c] = (bf16)f2bf(xv);
#pragma unroll
        for (int o = 0; o < 4; ++o) lg[o] += xv * wg[c * 4 + o];
#pragma unroll
        for (int o = 0; o < 16; ++o) le[o] += xv * we[c * 16 + o]; }
#pragma unroll
    for (int o = 0; o < 4; ++o) lg[o] = wsum(lg[o]) + bg[o];
#pragma unroll
    for (int o = 0; o < 16; ++o) le[o] = wsum(le[o]) + be[o];
    int gi = 0; float gv = lg[0];
#pragma unroll
    for (int o = 1; o < 4; ++o) if (lg[o] > gv) { gi = o; gv = lg[o]; }
    float gs = 0.f;
#pragma unroll
    for (int o = 0; o < 4; ++o) gs += expf(lg[o] - gv);
    const float gp = 1.f / gs; float l4[4];
#pragma unroll
    for (int o = 0; o < 4; ++o) l4[o] = gi == 0 ? le[o] : gi == 1 ? le[4 + o] : gi == 2 ? le[8 + o] : le[12 + o];
    int e0 = 0; float v0 = l4[0];
#pragma unroll
    for (int o = 1; o < 4; ++o) if (l4[o] > v0) { e0 = o; v0 = l4[o]; }
    int e1 = -1; float v1 = -INFINITY;
#pragma unroll
    for (int o = 0; o < 4; ++o) if (o != e0 && (e1 < 0 || l4[o] > v1)) { e1 = o; v1 = l4[o]; }
    const float p1 = expf(v1 - v0), w0 = gp / (1.f + p1), w1 = gp * p1 / (1.f + p1);
    if (lane == 0) { const int E0 = gi * 4 + e0, E1 = gi * 4 + e1;
        const unsigned p0 = atomicAdd(&cnt[E0], 1u); list[(size_t)E0 * T + p0] = t;
        const unsigned p1_ = atomicAdd(&cnt[E1], 1u); list[(size_t)E1 * T + p1_] = t;
        tokinfo[t] = make_uint4(((unsigned)E0 << 24) | p0, ((unsigned)E1 << 24) | p1_, __float_as_uint(w0), __float_as_uint(w1)); }
}
__global__ __launch_bounds__(256) void combine_ln(const bf16* __restrict__ x1, const bf16* __restrict__ Y, const uint4* __restrict__ tokinfo, const unsigned* __restrict__ cnt,
                                                  const float* __restrict__ g, const float* __restrict__ bb, bf16* xb, float* outf) {
    const int t = blockIdx.x * 4 + (threadIdx.x >> 6), lane = threadIdx.x & 63;
    const uint4 ti = tokinfo[t]; const int E0 = ti.x >> 24, E1 = ti.y >> 24; int b0 = 0, b1 = 0;
    for (int j = 0; j < 16; ++j) { const int pc = (((int)cnt[j] + 255) >> 8) << 8; if (j < E0) b0 += pc; if (j < E1) b1 += pc; }
    const size_t s0 = (size_t)b0 + (ti.x & 0xffffff), s1 = (size_t)b1 + (ti.y & 0xffffff); const float w0 = __uint_as_float(ti.z), w1 = __uint_as_float(ti.w);
    float v[16], s = 0.f;
#pragma unroll
    for (int j = 0; j < 16; ++j) { const int c = j * 64 + lane; v[j] = ALPHA * bf2f(x1[(size_t)t * D + c]) + w0 * bf2f(Y[s0 * D + c]) + w1 * bf2f(Y[s1 * D + c]); s += v[j]; }
    const float mu = wsum(s) * (1.f / 1024.f); float q = 0.f;
#pragma unroll
    for (int j = 0; j < 16; ++j) { v[j] -= mu; q += v[j] * v[j]; }
    const float rstd = rsqrtf(wsum(q) * (1.f / 1024.f) + LN_EPS);
#pragma unroll
    for (int j = 0; j < 16; ++j) { const int c = j * 64 + lane; const float o = v[j] * rstd * g[c] + bb[c]; if (outf) outf[(size_t)t * D + c] = o; else xb[(size_t)t * D + c] = (bf16)f2bf(o); }
}
}
namespace mk {
using namespace cfg;
#define LAS __attribute__((address_space(3)))
#define GAS __attribute__((address_space(1)))
typedef short bf16x8 __attribute__((ext_vector_type(8)));
typedef short s16x4 __attribute__((ext_vector_type(4)));
typedef float f32x4 __attribute__((ext_vector_type(4)));
typedef float f32x2 __attribute__((ext_vector_type(2)));
typedef float f32x16 __attribute__((ext_vector_type(16)));
typedef unsigned u32x4 __attribute__((ext_vector_type(4)));
typedef unsigned u32x2 __attribute__((ext_vector_type(2)));
typedef GAS unsigned gu32;

constexpr int BM = 256, BK = 64, HALF = 128, HTB = HALF * BK * 2, STAGE_BYTES = 8 * HTB, NXCD = 8, WGM = 8;
constexpr int RING_OFF = 0, RING_BYTES = 131072;
constexpr int TAB_OFF = RING_BYTES;
constexpr int TAB_RS = TAB_OFF;
constexpr int TAB_GIDX = TAB_OFF + 4096;
constexpr int TAB_TB = TAB_OFF + 10240;
constexpr int TAB_BYTES = 20480;
constexpr int LDSCTL_OFF = TAB_OFF + TAB_BYTES, MISC_OFF = LDSCTL_OFF + 320;
constexpr int LDS_BYTES = 155648;
static_assert(MISC_OFF + 128 <= LDS_BYTES, "LDS map");

__host__ __device__ __forceinline__ int lds_byte(int r, int c) { const int st = (r >> 4) * 2 + (c >> 5), rr = r & 15, cc = c & 31, ob = rr * 64 + cc * 2; return st * 1024 + (ob ^ (((ob >> 9) & 1) << 5)); }
__host__ __device__ __forceinline__ void stage_rc(int b, int& R, int& C) { const int st = b / 1024, sb = b % 1024, swz = sb ^ (((sb >> 9) & 1) << 5); R = (st >> 1) * 16 + swz / 64; C = (st & 1) * 32 + (swz % 64) / 2; }
__host__ __device__ __forceinline__ int perm32(int rho) { const int n = rho >> 4, i = rho & 15; return 8 * (i >> 2) + 4 * n + (i & 3); }
__device__ __forceinline__ unsigned cvt_pk_bf16(float lo, float hi) { unsigned r; asm volatile("v_cvt_pk_bf16_f32 %0, %1, %2" : "=v"(r) : "v"(lo), "v"(hi)); return r; }

struct Unit { const char* A; const char* B; int orow, ocol, slot; };

struct TileOrder {
    int nM, nN, nwg, G, c;
    __device__ void init(int nM_, int nN_, int G_, int c_) { nM = nM_; nN = nN_; nwg = nM * nN; G = G_; c = c_; }
    __device__ bool tile(int i, int& pm, int& pn) const {
        const long L = (long)i * G + c; if (L >= nwg) return false;
        int wgid = (int)L; { const int q = nwg / NXCD, r = nwg % NXCD, xcd = wgid % NXCD, off = wgid / NXCD; wgid = (xcd < r ? xcd * (q + 1) : r * (q + 1) + (xcd - r) * q) + off; }
        const int nig = WGM * nN, gid = wgid / nig, fm = gid * WGM, gsz = (nM - fm) < WGM ? (nM - fm) : WGM;
        pm = fm + ((wgid % nig) % gsz); pn = (wgid % nig) / gsz; return true;
    }
};

template <class Epi, class Sched, bool GATHER, bool MIDK>
__device__ __forceinline__ void gemm_phase(LAS unsigned char* lds, const int K, const Sched& S, const Epi& E, const LAS unsigned* gidx) {
    int tid_ = threadIdx.x; asm volatile("" : "+v"(tid_));
    const int tid = tid_, wid = __builtin_amdgcn_readfirstlane(tid >> 6), lane = tid & 63, wr = wid >> 2, wc = wid & 3, fr = lane & 15, fq = lane >> 4;
    const int nt = K / BK;
    unsigned voffB[2], voffC[2][2], voffN[2][2]; int gR[2], gC[2];
#pragma unroll
    for (int i = 0; i < 2; ++i) { int R, C; stage_rc(tid * 16 + i * 8192, R, C); const int Rb = (R & ~31) + perm32(R & 31);
        voffB[i] = (unsigned)(Rb * K + C) * 2u; gR[i] = R; gC[i] = C * 2;
        voffC[0][i] = (unsigned)(R * K + C) * 2u; voffC[1][i] = (unsigned)((R + HALF) * K + C) * 2u; voffN[0][i] = voffC[0][i]; voffN[1][i] = voffC[1][i]; }
    const size_t kstep = (size_t)(BK * 2);
    const size_t hstep = (size_t)HALF * K * 2;
    const unsigned ldsw = (unsigned)wid * 1024u;
    const int aoff = lds_byte(wr * 64 + fr, fq * 8), boff = lds_byte(wc * 32 + fr, fq * 8);
#define PG8_SA(b, h) (((b) * 2 + (h)) * HTB)
#define PG8_SB(b, h) ((4 + (b) * 2 + (h)) * HTB)
#define PG8_STB(bufoff, gbase) do { _Pragma("unroll") for (int _i = 0; _i < 2; ++_i) \
        __builtin_amdgcn_global_load_lds((const unsigned*)((const char*)(gbase) + voffB[_i]), (LAS unsigned*)(lds + (bufoff) + ldsw + _i * 8192), 16, 0, 0); } while (0)
#define PG8_STA(bufoff, gbase, VO, h) do { _Pragma("unroll") for (int _i = 0; _i < 2; ++_i) \
        __builtin_amdgcn_global_load_lds((const unsigned*)((const char*)(gbase) + (VO)[h][_i]), (LAS unsigned*)(lds + (bufoff) + ldsw + _i * 8192), 16, 0, 0); } while (0)
#define PG8_LDA(dst, b, h) do { _Pragma("unroll") for (int m = 0; m < 4; ++m) _Pragma("unroll") for (int k = 0; k < 2; ++k) dst[m][k] = *(const LAS bf16x8*)(lds + PG8_SA(b, h) + aoff + m * 2048 + k * 1024); } while (0)
#define PG8_LDB(dst, b, h) do { _Pragma("unroll") for (int n = 0; n < 2; ++n) _Pragma("unroll") for (int k = 0; k < 2; ++k) dst[n][k] = *(const LAS bf16x8*)(lds + PG8_SB(b, h) + boff + n * 2048 + k * 1024); } while (0)
#define PG8_MMA(ai, bj, At, Bt) do { __builtin_amdgcn_s_setprio(1); _Pragma("unroll") for (int m = 0; m < 4; ++m) _Pragma("unroll") for (int n = 0; n < 2; ++n) _Pragma("unroll") for (int k = 0; k < 2; ++k) \
        acc[ai][bj][m][n] = __builtin_amdgcn_mfma_f32_16x16x32_bf16(Bt[n][k], At[m][k], acc[ai][bj][m][n], 0, 0, 0); __builtin_amdgcn_s_setprio(0); } while (0)
#define PG8_WAIT_V(n) asm volatile("s_waitcnt vmcnt(" #n ")" ::: "memory")
#define PG8_WAIT_L(n) asm volatile("s_waitcnt lgkmcnt(" #n ")" ::: "memory")
#define PG8_BAR __builtin_amdgcn_s_barrier()
#define PG8_SCHED __builtin_amdgcn_sched_barrier(0)
#define PG8_GLOAD(VO, slot_) do { if constexpr (GATHER) { _Pragma("unroll") for (int _h = 0; _h < 2; ++_h) _Pragma("unroll") for (int _i = 0; _i < 2; ++_i) \
        (VO)[_h][_i] = gidx[(slot_) * 256 + _h * HALF + gR[_i]] * (unsigned)(K * 2) + (unsigned)gC[_i]; } } while (0)
    Unit cur, nxt; int ui = 0;
    if (!S.next(0, cur)) return;
    f32x4 acc[2][2][4][2];
#pragma unroll
    for (int a = 0; a < 2; ++a)
#pragma unroll
        for (int b = 0; b < 2; ++b)
#pragma unroll
            for (int m = 0; m < 4; ++m)
#pragma unroll
                for (int n = 0; n < 2; ++n) acc[a][b][m][n] = (f32x4){0.f, 0.f, 0.f, 0.f};
    bf16x8 At[4][2], B0[2][2], B1[2][2];
    const char* cA = cur.A; const char* cB = cur.B;
    PG8_GLOAD(voffC, cur.slot);
    E.prep(cur, 0, tid);
    PG8_STB(PG8_SB(0, 0), cB); PG8_STB(PG8_SB(0, 1), cB + hstep); PG8_STA(PG8_SA(0, 0), cA, voffC, 0); PG8_STA(PG8_SA(0, 1), cA, voffC, 1);
    if (wr == 1) PG8_BAR;
    PG8_WAIT_V(2); PG8_BAR;
    PG8_STB(PG8_SB(1, 0), cB + kstep); PG8_STA(PG8_SA(1, 0), cA + kstep, voffC, 0); PG8_STB(PG8_SB(1, 1), cB + hstep + kstep);
    PG8_WAIT_V(6); PG8_BAR;
    for (;;) {
        const bool has_next = S.next(ui + 1, nxt);
        const char* nA = has_next ? nxt.A : cA; const char* nB = has_next ? nxt.B : cB;
        if constexpr (GATHER) { if (has_next) PG8_GLOAD(voffN, nxt.slot); else { _Pragma("unroll") for (int _h = 0; _h < 2; ++_h) _Pragma("unroll") for (int _i = 0; _i < 2; ++_i) voffN[_h][_i] = voffC[_h][_i]; } }
        for (int t = 0; t < nt; t += 2) {
            const bool last = (t == nt - 2);
            const char* a1 = cA + (size_t)(t + 1) * kstep;
            const char* a2 = last ? nA : cA + (size_t)(t + 2) * kstep; const char* b2 = last ? nB : cB + (size_t)(t + 2) * kstep;
            const char* a3 = a2 + kstep; const char* b3 = b2 + kstep;
            unsigned vo2[2][2];
#pragma unroll
            for (int _h = 0; _h < 2; ++_h)
#pragma unroll
                for (int _i = 0; _i < 2; ++_i) vo2[_h][_i] = (GATHER && last) ? voffN[_h][_i] : voffC[_h][_i];
            if (last && has_next) E.prep(nxt, ui + 1, tid);
            PG8_LDB(B0, 0, 0); PG8_LDB(B1, 0, 1); PG8_SCHED; PG8_LDA(At, 0, 0); PG8_STA(PG8_SA(1, 1), a1, voffC, 1);
            PG8_WAIT_V(8); PG8_WAIT_L(0); PG8_BAR; PG8_MMA(0, 0, At, B0); PG8_MMA(0, 1, At, B1); PG8_BAR; PG8_SCHED;
            PG8_LDA(At, 0, 1); PG8_STB(PG8_SB(0, 0), b2); PG8_STB(PG8_SB(0, 1), b2 + hstep); PG8_STA(PG8_SA(0, 0), a2, vo2, 0);
            PG8_WAIT_V(8); PG8_WAIT_L(0); PG8_BAR; PG8_MMA(1, 0, At, B0); PG8_MMA(1, 1, At, B1); PG8_BAR; PG8_SCHED;
            PG8_LDB(B0, 1, 0); PG8_LDB(B1, 1, 1); PG8_SCHED; PG8_LDA(At, 1, 0); PG8_STA(PG8_SA(0, 1), a2, vo2, 1);
            PG8_WAIT_V(8); PG8_WAIT_L(0); PG8_BAR; PG8_MMA(0, 0, At, B0); PG8_MMA(0, 1, At, B1); PG8_BAR; PG8_SCHED;
            PG8_LDA(At, 1, 1); PG8_STB(PG8_SB(1, 0), b3); PG8_STB(PG8_SB(1, 1), b3 + hstep); PG8_STA(PG8_SA(1, 0), a3, vo2, 0);
            PG8_WAIT_V(8); PG8_WAIT_L(0); PG8_BAR; PG8_MMA(1, 0, At, B0); PG8_MMA(1, 1, At, B1); PG8_BAR; PG8_SCHED;
            if constexpr (MIDK) { if (t + 2 == (nt >> 1)) E.midk(acc, ui, wr, fr); }
        }
        if (wr == 0) PG8_BAR;
        E(acc, cur, ui, wr, wc, fr, fq);
        if (!has_next) break;
#pragma unroll
        for (int a = 0; a < 2; ++a)
#pragma unroll
            for (int b = 0; b < 2; ++b)
#pragma unroll
                for (int m = 0; m < 4; ++m)
#pragma unroll
                    for (int n = 0; n < 2; ++n) acc[a][b][m][n] = (f32x4){0.f, 0.f, 0.f, 0.f};
        cur = nxt; cA = nA; cB = nB; ++ui;
#pragma unroll
        for (int _h = 0; _h < 2; ++_h)
#pragma unroll
            for (int _i = 0; _i < 2; ++_i) voffC[_h][_i] = voffN[_h][_i];
        if (wr == 1) PG8_BAR;
    }
    PG8_WAIT_V(0);
    PG8_BAR;
#undef PG8_SA
#undef PG8_SB
#undef PG8_STB
#undef PG8_STA
#undef PG8_LDA
#undef PG8_LDB
#undef PG8_MMA
#undef PG8_WAIT_V
#undef PG8_WAIT_L
#undef PG8_BAR
#undef PG8_SCHED
#undef PG8_GLOAD
}
struct EpiProj {
    bf16* O; const LAS f32x4* RB; const LAS f32x4* RA;
    __device__ __forceinline__ void prep(const Unit&, int, int) const {}
    __device__ __forceinline__ void operator()(const f32x4 (&acc)[2][2][4][2], const Unit& u, int, int wr, int wc, int fr, int fq) const {
        const int row0 = u.orow + wr * 64 + fr, col0 = u.ocol + wc * 32 + 8 * fq;
        const bool isq = u.ocol < 512, dorope = (u.ocol < 1024) && ((wc & 1) == 0);
        const float sc = isq ? C2 : 1.f;
        float ca[8], sa[8];
        if (dorope) { const int ck = (u.orow & (NS - 1)) >> 8;
#pragma unroll
            for (int j = 0; j < 4; ++j) { const f32x4 t = RA[ck * 4 + j]; ca[2 * j] = t[0]; sa[2 * j] = t[1]; ca[2 * j + 1] = t[2]; sa[2 * j + 1] = t[3]; } }
        const float sgn = fq == 0 ? -1.f : 1.f; const bool act = fq < 2;
#pragma unroll
        for (int ai = 0; ai < 2; ++ai)
#pragma unroll
            for (int m = 0; m < 4; ++m) { const int dl = ai * HALF + wr * 64 + m * 16 + fr; bf16* rowp = O + (size_t)(row0 + ai * HALF + m * 16) * NPROJ + col0;
                float cc[8], ss[8];
                if (dorope) {
#pragma unroll
                    for (int j = 0; j < 4; ++j) { const f32x4 t = RB[dl * 4 + j];
                        const float c0 = ca[2 * j] * t[0] - sa[2 * j] * t[1], s0 = sa[2 * j] * t[0] + ca[2 * j] * t[1], c1 = ca[2 * j + 1] * t[2] - sa[2 * j + 1] * t[3], s1 = sa[2 * j + 1] * t[2] + ca[2 * j + 1] * t[3];
                        cc[2 * j] = act ? c0 : 1.f; ss[2 * j] = act ? sgn * s0 : 0.f; cc[2 * j + 1] = act ? c1 : 1.f; ss[2 * j + 1] = act ? sgn * s1 : 0.f; } }
#pragma unroll
                for (int bj = 0; bj < 2; ++bj) { float v[8];
#pragma unroll
                    for (int j = 0; j < 4; ++j) { v[j] = acc[ai][bj][m][0][j]; v[4 + j] = acc[ai][bj][m][1][j]; }
                    if (dorope) {
#pragma unroll
                        for (int j = 0; j < 8; ++j) { const float p = __shfl_xor(v[j], 16); v[j] = v[j] * cc[j] + p * ss[j]; } }
                    u32x4 w; w.x = cvt_pk_bf16(v[0] * sc, v[1] * sc); w.y = cvt_pk_bf16(v[2] * sc, v[3] * sc); w.z = cvt_pk_bf16(v[4] * sc, v[5] * sc); w.w = cvt_pk_bf16(v[6] * sc, v[7] * sc);
                    *(u32x4*)(rowp + bj * HALF) = w; } }
    }
};
struct EpiOut {
    bf16* PRE; const bf16* XB; const float* SSQ; LAS f32x2* RS;
    __device__ __forceinline__ void prep(const Unit& u, int ui, int tid) const {
        if (tid < 256) { const f32x4* p = (const f32x4*)(SSQ + (size_t)(u.orow + tid) * 16); const f32x4 a0 = p[0], a1 = p[1], r0 = p[2], r1 = p[3];
            const float sa = ((a0[0] + a0[1]) + (a0[2] + a0[3])) + ((a1[0] + a1[1]) + (a1[2] + a1[3])), sr = ((r0[0] + r0[1]) + (r0[2] + r0[3])) + ((r1[0] + r1[1]) + (r1[2] + r1[3]));
            const float ia = rsqrtf(sa * (1.f / 512.f) + RMS_EPS), ir = rsqrtf(sr * (1.f / 512.f) + RMS_EPS);
            RS[(ui & 1) * 256 + tid] = (f32x2){ia / ir, ir}; }
    }
    __device__ __forceinline__ void midk(f32x4 (&acc)[2][2][4][2], int ui, int wr, int fr) const {
#pragma unroll
        for (int ai = 0; ai < 2; ++ai)
#pragma unroll
            for (int m = 0; m < 4; ++m) { const float ra = RS[(ui & 1) * 256 + ai * HALF + wr * 64 + m * 16 + fr].x;
#pragma unroll
                for (int bj = 0; bj < 2; ++bj)
#pragma unroll
                    for (int n = 0; n < 2; ++n) acc[ai][bj][m][n] = acc[ai][bj][m][n] * ra; }
    }
    __device__ __forceinline__ void operator()(const f32x4 (&acc)[2][2][4][2], const Unit& u, int ui, int wr, int wc, int fr, int fq) const {
        const int col0 = u.ocol + wc * 32 + 8 * fq;
#pragma unroll
        for (int ai = 0; ai < 2; ++ai)
#pragma unroll
            for (int m = 0; m < 4; ++m) { const int rl = ai * HALF + wr * 64 + m * 16 + fr; const float sr = RS[(ui & 1) * 256 + rl].y; const size_t off = (size_t)(u.orow + rl) * D + col0;
#pragma unroll
                for (int bj = 0; bj < 2; ++bj) { const u32x4 xr = *(const u32x4*)(XB + off + bj * HALF); float v[8];
#pragma unroll
                    for (int j = 0; j < 4; ++j) { v[j] = acc[ai][bj][m][0][j] * sr; v[4 + j] = acc[ai][bj][m][1][j] * sr; }
#pragma unroll
                    for (int j = 0; j < 4; ++j) { v[2 * j] += ALPHA * __uint_as_float(xr[j] << 16); v[2 * j + 1] += ALPHA * __uint_as_float(xr[j] & 0xffff0000u); }
                    u32x4 w; w.x = cvt_pk_bf16(v[0], v[1]); w.y = cvt_pk_bf16(v[2], v[3]); w.z = cvt_pk_bf16(v[4], v[5]); w.w = cvt_pk_bf16(v[6], v[7]);
                    *(u32x4*)(PRE + off + bj * HALF) = w; } }
    }
};
struct EpiSwiglu {
    bf16* H;
    __device__ __forceinline__ void prep(const Unit&, int, int) const {}
    __device__ __forceinline__ void operator()(const f32x4 (&acc)[2][2][4][2], const Unit& u, int, int wr, int wc, int fr, int fq) const {
        const int col0 = u.ocol + wc * 32 + 8 * fq;
#pragma unroll
        for (int ai = 0; ai < 2; ++ai)
#pragma unroll
            for (int m = 0; m < 4; ++m) { float v[8];
#pragma unroll
                for (int n = 0; n < 2; ++n)
#pragma unroll
                    for (int j = 0; j < 4; ++j) { const float g = acc[ai][0][m][n][j], up = acc[ai][1][m][n][j]; v[4 * n + j] = g * __builtin_amdgcn_rcpf(1.f + __expf(-g)) * up; }
                u32x4 w; w.x = cvt_pk_bf16(v[0], v[1]); w.y = cvt_pk_bf16(v[2], v[3]); w.z = cvt_pk_bf16(v[4], v[5]); w.w = cvt_pk_bf16(v[6], v[7]);
                *(u32x4*)(H + (size_t)(u.orow + ai * HALF + wr * 64 + m * 16 + fr) * DEXP + col0) = w; }
    }
};
struct EpiPlain {
    bf16* O; int ldc;
    __device__ __forceinline__ void prep(const Unit&, int, int) const {}
    __device__ __forceinline__ void operator()(const f32x4 (&acc)[2][2][4][2], const Unit& u, int, int wr, int wc, int fr, int fq) const {
        const int col0 = u.ocol + wc * 32 + 8 * fq;
#pragma unroll
        for (int ai = 0; ai < 2; ++ai)
#pragma unroll
            for (int m = 0; m < 4; ++m) { bf16* rowp = O + (size_t)(u.orow + ai * HALF + wr * 64 + m * 16 + fr) * ldc + col0;
#pragma unroll
                for (int bj = 0; bj < 2; ++bj) { const f32x4 v0 = acc[ai][bj][m][0], v1 = acc[ai][bj][m][1];
                    u32x4 w; w.x = cvt_pk_bf16(v0[0], v0[1]); w.y = cvt_pk_bf16(v0[2], v0[3]); w.z = cvt_pk_bf16(v1[0], v1[1]); w.w = cvt_pk_bf16(v1[2], v1[3]);
                    *(u32x4*)(rowp + bj * HALF) = w; } }
    }
};
struct DenseOrder {
    TileOrder to; const char* A; const char* B; size_t tstep;
    __device__ void init(const bf16* A_, const bf16* B_, int M, int N, int K, int G, int c) { to.init(M / BM, N / BM, G, c); A = (const char*)A_; B = (const char*)B_; tstep = (size_t)BM * K * 2; }
    __device__ __forceinline__ bool next(int i, Unit& u) const { int pm, pn; if (!to.tile(i, pm, pn)) return false; u.A = A + (size_t)pm * tstep; u.B = B + (size_t)pn * tstep; u.orow = pm * BM; u.ocol = pn * BM; u.slot = 0; return true; }
};
struct MoeOrder {
    const LAS unsigned* TB; int G, c; const char* A; const char* W; size_t a_tile, w_exp, w_tile; int ocol_step; bool gather;
    __device__ __forceinline__ bool next(int i, Unit& u) const {
        const int L = i * G + c; const int MT = (int)TB[16]; if (L >= 4 * MT) return false;
        const int mtg = L >> 2, pn = L & 3; int e = 0;
#pragma unroll
        for (int j = 1; j < 16; ++j) e += ((int)TB[j] <= mtg) ? 1 : 0;
        u.A = gather ? A : A + (size_t)mtg * a_tile; u.B = W + (size_t)e * w_exp + (size_t)pn * w_tile; u.orow = mtg * BM; u.ocol = pn * ocol_step; u.slot = i; return true;
    }
};
}
namespace attn_body {
using bf16=unsigned short;
using bf16x8=__attribute__((ext_vector_type(8)))short;
using s16x4=__attribute__((ext_vector_type(4)))short;
using f32x16=__attribute__((ext_vector_type(16)))float;
using u32x4=__attribute__((ext_vector_type(4)))unsigned;
constexpr int BATCH=8,NHEAD=8,SEQ=4096,D=64,PQ=2560,PO=1024;
constexpr int NW=8,QBLK=32,QB=QBLK*NW,KVBLK=64,NQB=SEQ/QB;
constexpr int ATTN_UNIT_ROWS=QB;
__device__ __forceinline__ int crow(int r,int hi){return (r&3)+8*(r>>2)+4*hi;}
#define SBAR() __builtin_amdgcn_sched_barrier(0)
__device__ __forceinline__ void cmask(f32x16&p0,f32x16&p1,int jb,int qrel,int hi){
  const float NEG=-INFINITY; int kb=64*jb+4*hi;
  #pragma unroll
  for(int r=0;r<16;++r){int kv=kb+(r&3)+8*(r>>2); if(kv>qrel)p0[r]=NEG; if(kv+32>qrel)p1[r]=NEG;}
}

constexpr int NSLOT=3, SLOTB=8192;
constexpr int LDS_K=0, LDS_V=NSLOT*SLOTB, LDS_WS=2*NSLOT*SLOTB, LDS_OST=LDS_WS+NW*64*4, LDS_BYTES=LDS_OST+NW*4096;
constexpr float C2=0.125f*1.4426950408889634f;
__device__ __forceinline__ void glds16(const void*gsrc,unsigned lds_dst){unsigned keep;
  asm volatile("s_mov_b32 %0, m0\n\ts_mov_b32 m0, %2\n\ts_nop 0\n\tglobal_load_lds_dwordx4 %1, off\n\ts_mov_b32 m0, %0":"=&s"(keep):"v"(gsrc),"s"(lds_dst):"memory");}
__device__ __forceinline__ float max3f(float a,float b,float c){float r;asm("v_max3_f32 %0, %1, %2, %3":"=v"(r):"v"(a),"v"(b),"v"(c));return r;}
__device__ __forceinline__ float max2f(float a,float b){float r;asm("v_max_f32_e32 %0, %1, %2":"=v"(r):"v"(a),"v"(b));return r;}
__device__ __forceinline__ float fadd_s(float a,float b){float r;asm("v_add_f32_e32 %0, %1, %2":"=v"(r):"v"(a),"v"(b));return r;}
__device__ __forceinline__ float fsub_s(float a,float b){float r;asm("v_sub_f32_e32 %0, %1, %2":"=v"(r):"v"(a),"v"(b));return r;}
typedef float f32x2_t __attribute__((ext_vector_type(2))); typedef __bf16 bf16x2_t __attribute__((ext_vector_type(2)));
__device__ __forceinline__ unsigned cvtpk_s(float lo,float hi){f32x2_t v={lo,hi};bf16x2_t b=__builtin_convertvector(v,bf16x2_t);return __builtin_bit_cast(unsigned,b);}
#define WAIT_BAR(N) asm volatile("s_waitcnt vmcnt(" #N ") lgkmcnt(0)\n\ts_barrier":::"memory")

__device__ __forceinline__ void qkt(f32x16&p0,f32x16&p1,const char*Kslot,const bf16x8*qr,const f32x16&negm,int r32,int hi){
  const char*kb=Kslot+hi*1024+r32*16;
  #pragma unroll
  for(int d0=0;d0<4;++d0){
    const bf16x8 b0=*reinterpret_cast<const bf16x8*>(kb+d0*2048);
    const bf16x8 b1=*reinterpret_cast<const bf16x8*>(kb+d0*2048+512);
    if(d0==0){p0=__builtin_amdgcn_mfma_f32_32x32x16_bf16(b0,qr[0],negm,0,0,0);p1=__builtin_amdgcn_mfma_f32_32x32x16_bf16(b1,qr[0],negm,0,0,0);}
    else{p0=__builtin_amdgcn_mfma_f32_32x32x16_bf16(b0,qr[d0],p0,0,0,0);p1=__builtin_amdgcn_mfma_f32_32x32x16_bf16(b1,qr[d0],p1,0,0,0);}}
}
typedef __attribute__((address_space(3))) const char* lds_cptr;
typedef short v4i16_t __attribute__((ext_vector_type(4)));
__device__ __forceinline__ void kload8(bf16x8*kf,lds_cptr kp){
  kf[0]=*(const __attribute__((address_space(3))) bf16x8*)(kp);      kf[1]=*(const __attribute__((address_space(3))) bf16x8*)(kp+512);
  kf[2]=*(const __attribute__((address_space(3))) bf16x8*)(kp+2048); kf[3]=*(const __attribute__((address_space(3))) bf16x8*)(kp+2560);
  kf[4]=*(const __attribute__((address_space(3))) bf16x8*)(kp+4096); kf[5]=*(const __attribute__((address_space(3))) bf16x8*)(kp+4608);
  kf[6]=*(const __attribute__((address_space(3))) bf16x8*)(kp+6144); kf[7]=*(const __attribute__((address_space(3))) bf16x8*)(kp+6656);
}
__device__ __forceinline__ void kload2(bf16x8*kf,lds_cptr kp,int j){ kf[2*j]=*(const __attribute__((address_space(3))) bf16x8*)(kp+j*2048); kf[2*j+1]=*(const __attribute__((address_space(3))) bf16x8*)(kp+j*2048+512); }
__device__ __forceinline__ s16x4 vtr(lds_cptr p){ return __builtin_bit_cast(s16x4,__builtin_amdgcn_ds_read_tr16_b64_v4i16((__attribute__((address_space(3))) v4i16_t*)p)); }
__device__ __forceinline__ float rowmax(const f32x16&p0,const f32x16&p1){
  float a=max3f(p0[0],p0[1],p1[0]),b=max3f(p0[2],p0[3],p1[1]);a=max3f(a,p1[2],p1[3]);
  #pragma unroll
  for(int r=4;r<16;r+=4){a=max3f(a,p0[r],p0[r+1]);b=max3f(b,p0[r+2],p0[r+3]);a=max3f(a,p1[r],p1[r+1]);b=max3f(b,p1[r+2],p1[r+3]);}
  const float m=max2f(a,b);
  auto rr=__builtin_amdgcn_permlane32_swap(__float_as_uint(m),__float_as_uint(m),false,false);
  return max2f(__uint_as_float(rr[0]),__uint_as_float(rr[1]));
}
__device__ __forceinline__ void pv(f32x16*o,int vb,bf16x8 pa0,bf16x8 pa1,bf16x8 pa2,bf16x8 pa3){
  #pragma unroll
  for(int d0=0;d0<2;++d0){s16x4 lo[4],hi[4];
    #pragma unroll
    for(int ks=0;ks<4;++ks){
      asm volatile("ds_read_b64_tr_b16 %0,%1 offset:%c2":"=&v"(lo[ks]):"v"(vb),"i"(d0*4096+ks*1024):"memory");
      asm volatile("ds_read_b64_tr_b16 %0,%1 offset:%c2":"=&v"(hi[ks]):"v"(vb),"i"(d0*4096+ks*1024+512):"memory");}
    asm volatile("s_waitcnt lgkmcnt(0)":::"memory");SBAR();
    #define PK(k) (bf16x8){lo[k][0],lo[k][1],lo[k][2],lo[k][3],hi[k][0],hi[k][1],hi[k][2],hi[k][3]}
    o[d0]=__builtin_amdgcn_mfma_f32_32x32x16_bf16(pa0,PK(0),o[d0],0,0,0);
    o[d0]=__builtin_amdgcn_mfma_f32_32x32x16_bf16(pa1,PK(1),o[d0],0,0,0);
    o[d0]=__builtin_amdgcn_mfma_f32_32x32x16_bf16(pa2,PK(2),o[d0],0,0,0);
    o[d0]=__builtin_amdgcn_mfma_f32_32x32x16_bf16(pa3,PK(3),o[d0],0,0,0);
    #undef PK
  }
}

#ifndef ATTN_STORE16
#define ATTN_STORE16(p,v) (*(u32x4*)(p)=(v))
#endif
template<int THRL> __device__ __forceinline__ void attn_unit(int b,int h,int qb,const bf16*Q,const bf16*__restrict__ K,const bf16*__restrict__ V,bf16*O,const bf16*__restrict__ KM,float*SSQ,char*shm){
  int tid_=threadIdx.x; asm volatile("":"+v"(tid_)); const int tid=tid_,lane=tid&63,r32=lane&31,hi=lane>>5; const int wid=__builtin_amdgcn_readfirstlane(tid>>6);
  const long rowbase=(long)b*SEQ; const int q0=qb*QB;
  const bf16*Qw=Q+(rowbase+q0+wid*QBLK)*PQ+h*D;
  const bf16*Kh=K+rowbase*PQ+h*D,*Vh=V+rowbase*PQ+h*D;
  const unsigned lds0=(unsigned)(uintptr_t)shm;
  float*wsf=(float*)(shm+LDS_WS)+wid*64;
  const bf16*ksrc=Kh+(long)lane*PQ+wid*8;
  const bf16*vsrc=Vh+(long)(16*(wid&3)+(lane>>2))*PQ+(wid>>2)*32+(lane&3)*8;
  const unsigned kdst=lds0+LDS_K+wid*1024, vdst=lds0+LDS_V+wid*1024;
  #define KT(t) (((t)<4)?(NT-4+(t)):((t)-4))
  #define DMA_K(t,slot) glds16(ksrc+(long)KT(t)*KVBLK*PQ,(unsigned)__builtin_amdgcn_readfirstlane(kdst+(slot)))
  #define DMA_V(t,slot) glds16(vsrc+(long)KT(t)*KVBLK*PQ,(unsigned)__builtin_amdgcn_readfirstlane(vdst+(slot)))
  const int vb0=(int)(lds0+LDS_V)+((lane>>4)&1)*32+(lane&3)*8+(4*hi+((lane&15)>>2))*64;
  const char*Kbase=shm+LDS_K; bf16x8 kf[8];
  const lds_cptr shm3=(lds_cptr)shm; const lds_cptr kp0=shm3+LDS_K+hi*1024+r32*16; const lds_cptr vp0=shm3+LDS_V+((lane>>4)&1)*32+(lane&3)*8+(4*hi+((lane&15)>>2))*64;
  const int NT=(q0+QB)/KVBLK;
  { const bf16*kmsrc=KM+((long)(b*NHEAD+h)*16+(lane&15))*D+wid*8; glds16(kmsrc,(unsigned)__builtin_amdgcn_readfirstlane(lds0+LDS_OST+wid*1024)); }
  DMA_K(0,0);DMA_V(0,0);DMA_K(1,SLOTB);
  bf16x8 qr[4];
  #pragma unroll
  for(int d0=0;d0<4;++d0)qr[d0]=*reinterpret_cast<const bf16x8*>(&Qw[(long)r32*PQ+d0*16+hi*8]);
  float mhat=0.f,l_reg=0.f;f32x16 o[2];o[0]=f32x16{};o[1]=f32x16{};f32x16 negm=f32x16{};asm volatile("":"+v"(negm));
  const int qrel=wid*QBLK+r32;
  #define CMASK(P0,P1,t) do{ if((t)<4)cmask(P0,P1,(t),qrel,hi); }while(0)
  bool resc=false;
  #define START(P0,P1) do{ const float rm=rowmax(P0,P1); resc=false; \
    { const float dl=rm; mhat=fadd_s(mhat,dl); \
      _Pragma("unroll") for(int r=0;r<16;++r){P0[r]=fsub_s(P0[r],dl);P1[r]=fsub_s(P1[r],dl);} \
      _Pragma("unroll") for(int r=0;r<16;++r)negm[r]=-mhat; asm volatile("":"+v"(negm)); } \
    _Pragma("unroll") for(int r=0;r<16;++r)P0[r]=__builtin_amdgcn_exp2f(P0[r]); }while(0)
  #define RESC() do{ if(resc){ asm volatile("s_waitcnt lgkmcnt(0)":::"memory"); \
      _Pragma("unroll") for(int d_=0;d_<2;++d_) _Pragma("unroll") for(int r=0;r<16;++r)o[d_][r]*=wsf[crow(r,hi)]; } }while(0)
  f32x16 pA0,pA1,pB0,pB1;
  int sl_prev=0,sl_cur=0,sl_next=SLOTB;
  #define ROT() do{sl_prev=sl_cur;sl_cur=sl_next;sl_next=(sl_next==(NSLOT-1)*SLOTB)?0:sl_next+SLOTB;}while(0)
  DMA_K(2,2*SLOTB);
  WAIT_BAR(3);
  unsigned selmask=0u;
  { f32x16 g0=f32x16{}; const char*kb=shm+LDS_OST+hi*1024+r32*16;
    _Pragma("unroll") for(int d0=0;d0<4;++d0){ const bf16x8 b0=*reinterpret_cast<const bf16x8*>(kb+d0*2048); g0=__builtin_amdgcn_mfma_f32_32x32x16_bf16(b0,qr[d0],g0,0,0,0); }
    float own[8],oth[8],gv[16];
    _Pragma("unroll") for(int r=0;r<8;++r){ own[r]=g0[r]; oth[r]=__shfl_xor(own[r],32); }
    _Pragma("unroll") for(int j=0;j<4;++j){ gv[j]=hi?oth[j]:own[j]; gv[4+j]=hi?own[j]:oth[j]; gv[8+j]=hi?oth[4+j]:own[4+j]; gv[12+j]=hi?own[4+j]:oth[4+j]; }
    _Pragma("unroll") for(int j=0;j<16;++j) if(j>=qb) gv[j]=-INFINITY;
    _Pragma("unroll") for(int rnd=0;rnd<3;++rnd){ float m=gv[0]; _Pragma("unroll") for(int j=1;j<16;++j)m=fmaxf(m,gv[j]);
      bool found=!(m>-INFINITY); _Pragma("unroll") for(int j=0;j<16;++j){ const bool hit=!found&&(gv[j]==m); if(hit){selmask|=(1u<<j);gv[j]=-INFINITY;} found=found||hit; } } }
  qkt(pA0,pA1,Kbase,qr,negm,r32,hi);asm volatile("s_nop 15\n\ts_nop 7":"+v"(pA0),"+v"(pA1));CMASK(pA0,pA1,0);
  START(pA0,pA1);
  _Pragma("unroll") for(int r=0;r<16;++r)pA1[r]=__builtin_amdgcn_exp2f(pA1[r]);
  WAIT_BAR(0);
  DMA_K(3,0);DMA_V(1,SLOTB);
  ROT();
  kload8(kf,kp0+sl_cur);
  WAIT_BAR(2);
  s16x4 vlo[8],vhi[8]; u32x4 pw0,pw1,pw2,pw3;
  #define PKW(P,B) cvtpk_s(P[B],P[B+1])
  #define PAF(k) __builtin_bit_cast(bf16x8,pw##k)
  #define VFR(i) (bf16x8){vlo[i][0],vlo[i][1],vlo[i][2],vlo[i][3],vhi[i][0],vhi[i][1],vhi[i][2],vhi[i][3]}
  #define PIN(x) asm volatile("":"+v"(x))
  #define MX3(a,b,c) __builtin_fmaxf(__builtin_fmaxf((a),(b)),(c))
  #define GAPA(MF,A0,A1,A2,A3,W0,W1,PW) do{ MF; sacc+=A0; sacc+=A1; sacc+=A2; sacc+=A3; PIN(sacc); W0; W1; PIN(PW); SBAR(); }while(0)
  #define EX(v) __builtin_amdgcn_exp2f(v)
  #define GAPB(MF,X,B) do{ MF; X[B]=EX(X[B]); X[B+1]=EX(X[B+1]); X[B+2]=EX(X[B+2]); X[B+3]=EX(X[B+3]); PIN(X); SBAR(); }while(0)
  #define VRD(i) do{ vlo[i]=vtr(vp_+(((i)>>2)*4096+((i)&3)*1024)); vhi[i]=vtr(vp_+(((i)>>2)*4096+((i)&3)*1024+512)); }while(0)
  #define KRD(G,j) do{ if(G){ kload2(kf,kp0+sl_next,j); SBAR(); } }while(0)
  #define STEP(C0,C1,P0,P1,t,GK,GV,GL) do{ SBAR(); \
    { const bool on_=((t)<4)||(((selmask>>(((t)-4)>>2))&1u)!=0u); const float nm_=on_?-mhat:-1.0e30f; _Pragma("unroll") for(int r=0;r<16;++r)negm[r]=nm_; asm volatile("":"+v"(negm)); } \
    const lds_cptr vp_=vp0+sl_prev; \
    VRD(0); SBAR(); float sacc=(P0[0]+P0[1]); \
    GAPA(C0=__builtin_amdgcn_mfma_f32_32x32x16_bf16(kf[0],qr[0],negm,0,0,0), P0[2],P0[3],P0[4],P0[5],     pw0[0]=PKW(P0,0), pw0[1]=PKW(P0,2), pw0); \
    VRD(4); SBAR(); GAPA(C1=__builtin_amdgcn_mfma_f32_32x32x16_bf16(kf[1],qr[0],negm,0,0,0), P0[6],P0[7],P0[8],P0[9],     pw0[2]=PKW(P0,4), pw0[3]=PKW(P0,6), pw0); \
    VRD(1); SBAR(); GAPA(C0=__builtin_amdgcn_mfma_f32_32x32x16_bf16(kf[2],qr[1],C0,0,0,0),   P0[10],P0[11],P0[12],P0[13], pw1[0]=PKW(P0,8), pw1[1]=PKW(P0,10), pw1); \
    VRD(5); SBAR(); GAPA(C1=__builtin_amdgcn_mfma_f32_32x32x16_bf16(kf[3],qr[1],C1,0,0,0),   P0[14],P0[15],P1[0],P1[1],   pw1[2]=PKW(P0,12),pw1[3]=PKW(P0,14), pw1); \
    VRD(2); SBAR(); GAPA(C0=__builtin_amdgcn_mfma_f32_32x32x16_bf16(kf[4],qr[2],C0,0,0,0),   P1[2],P1[3],P1[4],P1[5],     pw2[0]=PKW(P1,0), pw2[1]=PKW(P1,2), pw2); \
    VRD(6); SBAR(); GAPA(C1=__builtin_amdgcn_mfma_f32_32x32x16_bf16(kf[5],qr[2],C1,0,0,0),   P1[6],P1[7],P1[8],P1[9],     pw2[2]=PKW(P1,4), pw2[3]=PKW(P1,6), pw2); \
    VRD(3); SBAR(); GAPA(C0=__builtin_amdgcn_mfma_f32_32x32x16_bf16(kf[6],qr[3],C0,0,0,0),   P1[10],P1[11],P1[12],P1[13], pw3[0]=PKW(P1,8), pw3[1]=PKW(P1,10), pw3); \
    VRD(7); SBAR(); GAPA(C1=__builtin_amdgcn_mfma_f32_32x32x16_bf16(kf[7],qr[3],C1,0,0,0),   P1[14],P1[15],0.f,0.f,       pw3[2]=PKW(P1,12),pw3[3]=PKW(P1,14), pw3); \
    l_reg+=sacc; \
    if(GK){DMA_K((t)+3,sl_cur);} if(GV){DMA_V((t)+1,sl_next);} \
    CMASK(C0,C1,t); \
    { float a=MX3(C0[0],C0[1],C1[0]),b=MX3(C0[2],C0[3],C1[1]); a=MX3(a,C1[2],C1[3]); \
      _Pragma("unroll") for(int r=4;r<16;r+=4){a=MX3(a,C0[r],C0[r+1]);b=MX3(b,C0[r+2],C0[r+3]);a=MX3(a,C1[r],C1[r+1]);b=MX3(b,C1[r+2],C1[r+3]);} \
      float rm=__builtin_fmaxf(a,b); { auto rr=__builtin_amdgcn_permlane32_swap(__float_as_uint(rm),__float_as_uint(rm),false,false); rm=__builtin_fmaxf(__uint_as_float(rr[0]),__uint_as_float(rr[1])); } \
      resc=false; \
      if(__builtin_expect(__any(rm>(float)THRL),0)){ const float dl=__builtin_fmaxf(rm,0.f); mhat+=dl; \
        _Pragma("unroll") for(int r=0;r<16;++r){C0[r]-=dl;C1[r]-=dl;} \
        _Pragma("unroll") for(int r=0;r<16;++r)negm[r]=-mhat; asm volatile("":"+v"(negm)); \
        const float f=__builtin_amdgcn_exp2f(-dl); l_reg*=f; if(hi==0)wsf[r32]=f; resc=true; } } \
    SBAR(); \
    GAPB(o[0]=__builtin_amdgcn_mfma_f32_32x32x16_bf16(PAF(0),VFR(0),o[0],0,0,0), C0,0); \
    GAPB(o[1]=__builtin_amdgcn_mfma_f32_32x32x16_bf16(PAF(0),VFR(4),o[1],0,0,0), C0,4); \
    KRD(GL,0); GAPB(o[0]=__builtin_amdgcn_mfma_f32_32x32x16_bf16(PAF(1),VFR(1),o[0],0,0,0), C0,8); \
    KRD(GL,1); GAPB(o[1]=__builtin_amdgcn_mfma_f32_32x32x16_bf16(PAF(1),VFR(5),o[1],0,0,0), C0,12); \
    KRD(GL,2); GAPB(o[0]=__builtin_amdgcn_mfma_f32_32x32x16_bf16(PAF(2),VFR(2),o[0],0,0,0), C1,0); \
    KRD(GL,3); GAPB(o[1]=__builtin_amdgcn_mfma_f32_32x32x16_bf16(PAF(2),VFR(6),o[1],0,0,0), C1,4); \
    GAPB(o[0]=__builtin_amdgcn_mfma_f32_32x32x16_bf16(PAF(3),VFR(3),o[0],0,0,0), C1,8); \
    GAPB(o[1]=__builtin_amdgcn_mfma_f32_32x32x16_bf16(PAF(3),VFR(7),o[1],0,0,0), C1,12); \
    }while(0)
  int t=1;
  for(;t+5<NT;t+=2){
    STEP(pB0,pB1,pA0,pA1,t,true,true,true);     WAIT_BAR(2); RESC(); ROT();
    STEP(pA0,pA1,pB0,pB1,t+1,true,true,true);   WAIT_BAR(2); RESC(); ROT();
  }
  #define ENDW(tt) do{ if((tt)+3<NT){WAIT_BAR(2);} else if((tt)+2<NT){WAIT_BAR(1);} else {WAIT_BAR(0);} }while(0)
  for(;t+1<NT;t+=2){
    STEP(pB0,pB1,pA0,pA1,t,(t+3<NT),(t+1<NT),(t+1<NT));       ENDW(t);   RESC(); ROT();
    STEP(pA0,pA1,pB0,pB1,t+1,(t+4<NT),(t+2<NT),(t+2<NT));     ENDW(t+1); RESC(); ROT();
  }
  STEP(pB0,pB1,pA0,pA1,NT-1,false,false,false); RESC();
  { float sacc=pB0[0]+pB0[1]; _Pragma("unroll") for(int r=2;r<16;++r)sacc+=pB0[r]; _Pragma("unroll") for(int r=0;r<16;++r)sacc+=pB1[r]; l_reg+=sacc;
    pw0=(u32x4){PKW(pB0,0),PKW(pB0,2),PKW(pB0,4),PKW(pB0,6)};pw1=(u32x4){PKW(pB0,8),PKW(pB0,10),PKW(pB0,12),PKW(pB0,14)};pw2=(u32x4){PKW(pB1,0),PKW(pB1,2),PKW(pB1,4),PKW(pB1,6)};pw3=(u32x4){PKW(pB1,8),PKW(pB1,10),PKW(pB1,12),PKW(pB1,14)};
    SBAR(); pv(o,vb0+sl_cur,PAF(0),PAF(1),PAF(2),PAF(3)); }
  #undef PKW
  #undef PAF
  #undef VFR
  #undef PIN
  #undef MX3
  #undef GAPA
  #undef GAPB
  #undef EX
  #undef VRD
  #undef KRD
  #undef STEP
  #undef ENDW
  {auto rr=__builtin_amdgcn_permlane32_swap(__float_as_uint(l_reg),__float_as_uint(l_reg),false,false);l_reg=__uint_as_float(rr[0])+__uint_as_float(rr[1]);}
  if(hi==0)wsf[32+r32]=l_reg;asm volatile("s_waitcnt lgkmcnt(0)":::"memory");
  float rli[16];
  #pragma unroll
  for(int r=0;r<16;++r)rli[r]=__builtin_amdgcn_rcpf(wsf[32+crow(r,hi)]);
  bf16*Ow=O+(rowbase+q0+wid*QBLK)*PO+h*D; float*Sw=SSQ+(rowbase+q0+wid*QBLK)*16+h;
  { bf16*stg=(bf16*)(shm+LDS_OST)+wid*2048;
    #pragma unroll
    for(int r=0;r<16;++r){const int orow=crow(r,hi);
      #pragma unroll
      for(int d0=0;d0<2;++d0)stg[orow*64+d0*32+r32]=(bf16)f2bf(o[d0][r]*rli[r]);}
    asm volatile("s_waitcnt lgkmcnt(0)":::"memory");
    #pragma unroll
    for(int i=0;i<4;++i){const int row=i*8+(lane>>3),ch=lane&7; const u32x4 v=*(const u32x4*)(stg+row*64+ch*8); ATTN_STORE16(Ow+(long)row*PO+ch*8,v);
      float q=0.f; _Pragma("unroll") for(int e=0;e<4;++e){ const float lo=__uint_as_float(v[e]<<16),hi2=__uint_as_float(v[e]&0xffff0000u); q+=lo*lo+hi2*hi2; }
      q+=__shfl_xor(q,1); q+=__shfl_xor(q,2); q+=__shfl_xor(q,4); if(ch==0)Sw[(long)row*16]=q; } }
  asm volatile("s_waitcnt lgkmcnt(0)\n\ts_barrier":::"memory");
  #undef DMA_K
  #undef KT
  #undef DMA_V
  #undef CMASK
  #undef START
  #undef RESC
  #undef ROT
}
constexpr int ATTN_LDS_BYTES=LDS_BYTES;
struct AttnTensors { const bf16* Q; const bf16* K; const bf16* V; bf16* O; const bf16* KM; float* SSQ; };
struct AttnUnit { int bh; int qb; };
struct StaticOrder {
  int vcu, nvcu;
  __device__ __forceinline__ explicit StaticOrder(int grid,int block):vcu((grid%8==0)?(block%8)*(grid/8)+block/8:block),nvcu(grid){}
  __device__ __forceinline__ bool next(int i,AttnUnit&u)const{ const int item=vcu+(i>>2)*nvcu; if(item>=256)return false; const int s=item&3,j=i&3; u.bh=item>>2; u.qb=(j==0)?15-s:(j==1)?8+s:(j==2)?7-s:s; return true; }
  __device__ __forceinline__ void a_ready(const AttnUnit&)const{}
  __device__ __forceinline__ void done(const AttnUnit&)const{}
};
template<class Sched,int THRL=8> __device__ __forceinline__ void attn_phase(char*lds,const AttnTensors&T,const Sched&S){
  AttnUnit u;
  for(int i=0;S.next(i,u);++i){ S.a_ready(u); attn_unit<THRL>(u.bh/NHEAD,u.bh%NHEAD,u.qb,T.Q,T.K,T.V,T.O,T.KM,T.SSQ,lds); S.done(u); }
}
#undef SBAR
#undef WAIT_BAR
}
namespace mk {
#define XB_TMO      128
#define XB_XCNT(j)  (256  + 64 * (j))
#define XB_XSUB(j)  (1280 + 64 * (j))
#define XB_XGEN(j)  (2304 + 64 * (j))
#define XB_TOP      3328
#define XB_TOPGEN   3392
#define XCD_BAR_WORDS 3456
#define XB_SPIN_CAP (1u << 18)

__device__ __forceinline__ unsigned xb_ld(unsigned* p)              { return __hip_atomic_load(p, __ATOMIC_RELAXED, __HIP_MEMORY_SCOPE_AGENT); }
__device__ __forceinline__ unsigned xb_add(unsigned* p, unsigned v) { return __hip_atomic_fetch_add(p, v, __ATOMIC_RELAXED, __HIP_MEMORY_SCOPE_AGENT); }
__device__ __forceinline__ unsigned xb_xcc_id() { return (unsigned)__builtin_amdgcn_s_getreg((3 << 11) | 20) & 0xFu; }
#define XB_SPIN(cond, bar) do { unsigned _sp = 0; while (cond) { __builtin_amdgcn_s_sleep(1); \
    if ((++_sp & 255u) == 0u) { if (xb_ld(&(bar)[XB_TMO])) break; if (_sp > XB_SPIN_CAP) { atomicAdd(&(bar)[XB_TMO], 1u); break; } } } } while (0)

struct XcdBarrier {
    unsigned* bar; unsigned x;
    volatile LAS unsigned* st;
};

__device__ __forceinline__ XcdBarrier xcd_barrier_post(unsigned* bar, volatile LAS unsigned* st) {
    XcdBarrier b; b.bar = bar; b.x = xb_xcc_id(); b.st = st;
    if (threadIdx.x == 0) (void)xb_add(&bar[XB_XCNT(b.x)], 1u);
    return b;
}
__device__ __forceinline__ void xcd_barrier_complete(unsigned* bar, unsigned x, unsigned& nloc, unsigned& nx) {
    const unsigned G = gridDim.x * gridDim.y * gridDim.z;
    unsigned sum, cnt, mine, sp = 0u;
    for (;;) {
        sum = 0u; cnt = 0u; mine = 0u;
#pragma unroll
        for (unsigned j = 0; j < 16; ++j) { const unsigned c = xb_ld(&bar[XB_XCNT(j)]); sum += c; cnt += (c > 0u) ? 1u : 0u; mine = (j == x) ? c : mine; }
        if (sum == G) break;
        __builtin_amdgcn_s_sleep(1);
        if ((++sp & 255u) == 0u) { if (xb_ld(&bar[XB_TMO])) break; if (sp > XB_SPIN_CAP) { atomicAdd(&bar[XB_TMO], 1u); break; } }
    }
    nloc = mine > 0u ? mine : 1u; nx = cnt > 0u ? cnt : 1u;
}

__device__ __forceinline__ void xcd_barrier(const XcdBarrier& b) {
    asm volatile("s_waitcnt vmcnt(0)" ::: "memory");
    __syncthreads();
    if (threadIdx.x == 0) {
        unsigned* bar = b.bar;
        __builtin_amdgcn_s_waitcnt(0);
        unsigned nloc = b.st[0], nx = b.st[1];
        if (nloc == 0u) { xcd_barrier_complete(bar, b.x, nloc, nx); b.st[0] = nloc; b.st[1] = nx; }
        const unsigned old = xb_add(&bar[XB_XSUB(b.x)], 1u);
        const unsigned gen = old / nloc;
        if (old + 1u == (gen + 1u) * nloc) {
            __builtin_amdgcn_fence(__ATOMIC_RELEASE, "agent");
            asm volatile("s_waitcnt vmcnt(0)" ::: "memory");
            const unsigned og = xb_add(&bar[XB_TOP], 1u);
            const unsigned tg = og / nx;
            if (og + 1u == (tg + 1u) * nx) xb_add(&bar[XB_TOPGEN], 1u);
            else XB_SPIN(xb_ld(&bar[XB_TOPGEN]) == tg, bar);
            __builtin_amdgcn_fence(__ATOMIC_ACQUIRE, "agent");
            xb_add(&bar[XB_XGEN(b.x)], 1u);
            asm volatile("s_waitcnt vmcnt(0)" ::: "memory");
        } else {
            XB_SPIN(xb_ld(&bar[XB_XGEN(b.x)]) == gen, bar);
            __builtin_amdgcn_fence(__ATOMIC_ACQUIRE, "agent");
            asm volatile("s_waitcnt vmcnt(0)" ::: "memory");
        }
    }
    __syncthreads();
}
#define RLX_AGENT __ATOMIC_RELAXED, __HIP_MEMORY_SCOPE_AGENT
#define LDS_WAIT() asm volatile("s_waitcnt lgkmcnt(0)" ::: "memory")
#define VM_WAIT() asm volatile("s_waitcnt vmcnt(0)" ::: "memory")
constexpr int NWAVES = 8;
struct Args { const float* in[23]; float* out; unsigned char* ws; int ph_lo, ph_hi, skip, pad; };
struct Frame {
    LAS unsigned char* lds; unsigned char* lds_gen; volatile LAS unsigned* MISC; gu32* ctl;
    int tid, lane, wave, vcu, G;
};
__device__ __forceinline__ float wave_sum(float v) {
#pragma unroll
    for (int o = 1; o < 64; o <<= 1) v += __shfl_xor(v, o);
    return v;
}
__device__ __forceinline__ void p0_transpose_item(const float* W, int K, int N, bf16* WT, int k0, int n0, int drow0, const float* kscale, LAS float* scr, int lane) {
    float wv[32];
#pragma unroll
    for (int i = 0; i < 32; ++i) wv[i] = W[(size_t)(k0 + 2 * i + (lane >> 5)) * N + n0 + (lane & 31)];
#pragma unroll
    for (int i = 0; i < 32; ++i) { const int kk = 2 * i + (lane >> 5); float v = wv[i]; if (kscale) v *= kscale[k0 + kk]; scr[kk * 33 + (lane & 31)] = v; }
    LDS_WAIT(); asm volatile("" ::: "memory");
    const int c = lane & 7;
#pragma unroll
    for (int j = 0; j < 4; ++j) { const int n = (lane >> 3) + 8 * j; const LAS float* s = scr + (8 * c) * 33 + n;
        u32x4 o; o.x = pk2(s[0 * 33], s[1 * 33]); o.y = pk2(s[2 * 33], s[3 * 33]); o.z = pk2(s[4 * 33], s[5 * 33]); o.w = pk2(s[6 * 33], s[7 * 33]);
        *(GAS u32x4*)(WT + (size_t)(drow0 + n) * K + k0 + 8 * c) = o; }
    LDS_WAIT(); asm volatile("" ::: "memory");
}
__device__ __forceinline__ void p0_prologue(Frame& F, const __attribute__((address_space(4))) Args* a) {
    LAS float* scr = (LAS float*)(F.lds + RING_OFF + F.wave * 16384);
    const int gw = F.vcu * NWAVES + F.wave, NGW = F.G * NWAVES;
    unsigned char* ws = a->ws;
    constexpr int I_IN = 16 * 80, I_OUT = 16 * 32, I_G = 16 * 256, I_U = 16 * 256, I_D = 16 * 256, I_L = I_IN + I_OUT + I_G + I_U + I_D;
    for (int it = gw; it < 2 * I_L; it += NGW) {
        const int l = it / I_L; int r = it % I_L;
        if (r < I_IN) { const int kb = r / 80, nb = r % 80; p0_transpose_item(a->in[1] + (size_t)l * D * NPROJ, D, NPROJ, (bf16*)(ws + WS_WIN) + (size_t)l * NPROJ * D, 64 * kb, 32 * nb, 32 * nb, nullptr, scr, F.lane); continue; } r -= I_IN;
        if (r < I_OUT) { const int kb = r / 32, nb = r % 32; const float* ks = (kb < 8) ? a->in[9] + l * 512 : a->in[10] + l * 512 - 512;
            p0_transpose_item(a->in[11] + (size_t)l * D * D, D, D, (bf16*)(ws + WS_WOUT) + (size_t)l * D * D, 64 * kb, 32 * nb, 32 * nb, ks, scr, F.lane); continue; } r -= I_OUT;
        if (r < I_G + I_U) { const int up = r >= I_G; if (up) r -= I_G; const int e = r / 256, q = r % 256, kb = q / 16, nb = q % 16, n0 = 32 * nb;
            p0_transpose_item(a->in[up ? 19 : 18] + ((size_t)l * 16 + e) * D * DEXP, D, DEXP, (bf16*)(ws + WS_WGU) + ((size_t)l * 16 + e) * 1024 * D, 64 * kb, n0, (n0 >> 7) * 256 + (up ? 128 : 0) + (n0 & 127), nullptr, scr, F.lane); continue; } r -= I_G + I_U;
        { const int e = r / 256, q = r % 256, kb = q / 32, nb = q % 32;
            p0_transpose_item(a->in[20] + ((size_t)l * 16 + e) * DEXP * D, DEXP, D, (bf16*)(ws + WS_WD) + ((size_t)l * 16 + e) * D * DEXP, 64 * kb, 32 * nb, 32 * nb, nullptr, scr, F.lane); }
    }
    const int gt = F.vcu * (NWAVES * 64) + F.tid, NGT = F.G * NWAVES * 64;
    for (int i = gt; i < 2 * 2 * 8 * 64 * 64; i += NGT) { const int c = i & 63, d = (i >> 6) & 63, n = (i >> 12) & 7, mat = (i >> 15) & 1, l = i >> 16;
        ((bf16*)(ws + WS_WRG))[i] = (bf16)f2bf(a->in[mat ? 6 : 4][(((size_t)l * 8 + n) * 64 + c) * 64 + d]); }
    for (int i = gt; i < 2 * 512; i += NGT) ((float*)(ws + WS_SP))[i] = log1pf(expf(-a->in[8][i]));
    for (int i = gt; i < NS * 8; i += NGT) { const int j = i & 7, s = i >> 3; const float inv = powf(500000.0f, -(float)j / 8.0f), ang = (float)s * inv; ((float2*)(ws + WS_ROPE))[i] = make_float2(cosf(ang), sinf(ang)); }
    for (int m = gw; m < T; m += NGW) { const GAS f32x4* xr = (const GAS f32x4*)(a->in[0] + (size_t)m * D) + F.lane; GAS u32x2* o = (GAS u32x2*)((bf16*)(ws + WS_XB) + (size_t)m * D) + F.lane;
#pragma unroll
        for (int j = 0; j < 4; ++j) { const f32x4 v = xr[64 * j]; o[64 * j] = (u32x2){pk2(v[0], v[1]), pk2(v[2], v[3])}; } }
}
__device__ __forceinline__ void kmean_item(Frame& F, int item, const bf16* PROJ, bf16* KM) {
    const int b = item >> 4, blk = item & 15, cg = F.tid & 63, rg = F.tid >> 6;
    const bf16* base = PROJ + ((size_t)b * NS + blk * 256) * NPROJ + KOFF + cg * 8;
    float s[8] = {0.f, 0.f, 0.f, 0.f, 0.f, 0.f, 0.f, 0.f};
#pragma unroll 4
    for (int i = 0; i < 32; ++i) { const u32x4 v = *(const u32x4*)(base + (size_t)(rg + 8 * i) * NPROJ);
#pragma unroll
        for (int e = 0; e < 4; ++e) { s[2 * e] += __uint_as_float(v[e] << 16); s[2 * e + 1] += __uint_as_float(v[e] & 0xffff0000u); } }
    LAS float* part = (LAS float*)(F.lds + RING_OFF);
#pragma unroll
    for (int e = 0; e < 8; ++e) part[rg * 512 + cg * 8 + e] = s[e];
    __syncthreads();
    { const int col = F.tid; float t = 0.f;
#pragma unroll
        for (int r = 0; r < 8; ++r) t += part[r * 512 + col];
        KM[(((size_t)b * NH + (col >> 6)) * NBLK + blk) * HD + (col & 63)] = (bf16)f2bf(t * (1.f / 256.f)); }
    __syncthreads();
}
constexpr int RG_PITCH = 144, RG_XR = 0, RG_XC = 260 * RG_PITCH, RG_GR = RG_XC + 256 * RG_PITCH, RG_WC = RG_GR + 256 * RG_PITCH, RG_SM = RG_WC + 8 * 64 * 8, RG_END = RG_SM + 10 * 256;
static_assert(RG_END <= RING_BYTES && (RG_XC % 16) == 0 && (RG_GR % 16) == 0 && (RG_WC % 16) == 0 && 2 * 64 * RG_PITCH <= TAB_BYTES, "rglru LDS map");
__device__ __forceinline__ float one_minus_exp(float x) {
    const float p = x * (1.f + x * (0.5f + x * (0.16666667f + x * (0.041666668f + x * 0.0083333338f))));
    return x > -0.25f ? -p : 1.f - __expf(x);
}
template <bool FINAL>
__device__ __forceinline__ void rglru_phase(Frame& F, const bf16* PROJ, const float* conv_w, const float* conv_b, const bf16* WRG, const float* b_a, const float* b_i,
                                            const float* sp, float2* SUMM, bf16* MIX, float* SSQ) {
    LAS unsigned char* L = F.lds + RING_OFF; LAS unsigned char* WT = F.lds + TAB_OFF; LAS float* SM = (LAS float*)(L + RG_SM);
    const int tid = F.tid, lane = F.lane, w = F.wave, r32 = lane & 31, hh = lane >> 5;
    int cur_n = -1;
    u32x4 xr_reg[5], gr_reg[4];
#define RG_LOAD(it_) do { const int n_ = (it_) & 7, ck_ = ((it_) >> 3) & 15, b_ = (it_) >> 7; const size_t t0_ = (size_t)b_ * NS + (size_t)ck_ * 256; \
        _Pragma("unroll") for (int k = 0; k < 5; ++k) { const int e_ = tid + 512 * k, j = e_ >> 3, c8 = e_ & 7; xr_reg[k] = (u32x4){0u, 0u, 0u, 0u}; \
            if (e_ < 259 * 8 && !(ck_ == 0 && j < 3)) xr_reg[k] = *(const u32x4*)(PROJ + (t0_ + j - 3) * NPROJ + XROFF + n_ * 64 + c8 * 8); } \
        if (FINAL) { _Pragma("unroll") for (int k = 0; k < 4; ++k) { const int e_ = tid + 512 * k, j = e_ >> 3, c8 = e_ & 7; gr_reg[k] = *(const u32x4*)(PROJ + (t0_ + j) * NPROJ + GROFF + n_ * 64 + c8 * 8); } } } while (0)
#define RG_H0(it_, par_) do { if (FINAL && w == 0) { const int n_ = (it_) & 7, ck_ = ((it_) >> 3) & 15, b_ = (it_) >> 7; float2 sm_[15]; \
        _Pragma("unroll") for (int c = 0; c < 15; ++c) { sm_[c] = make_float2(1.f, 0.f); if (c < ck_) sm_[c] = SUMM[((size_t)b_ * 16 + c) * 512 + n_ * 64 + lane]; } \
        float h_ = 0.f; _Pragma("unroll") for (int c = 0; c < 15; ++c) h_ = sm_[c].x * h_ + sm_[c].y; SM[512 + 64 * (par_) + lane] = h_; } } while (0)
    int it = F.vcu, par = 0;
    if (it < NB * 16 * 8) { RG_LOAD(it); RG_H0(it, 0); }
    for (; it < NB * 16 * 8; it += F.G) {
        const int n = it & 7, ck = (it >> 3) & 15, b = it >> 7; const size_t t0 = (size_t)b * NS + (size_t)ck * 256;
        if (n != cur_n) {
            cur_n = n;
            for (int e = tid; e < 2 * 64 * 8; e += 512) { const int c8 = e & 7, row = e >> 3; *(LAS u32x4*)(WT + row * RG_PITCH + c8 * 16) = *(const u32x4*)(WRG + ((size_t)((row >> 6) * 8 + n) * 64 + (row & 63)) * 64 + c8 * 8); }
            if (tid < 256) SM[tid] = conv_w[(tid >> 6) * 512 + n * 64 + (tid & 63)];
            else if (tid < 320) SM[tid] = conv_b[n * 64 + tid - 256];
            else if (tid < 384) SM[tid] = b_a[n * 64 + tid - 320];
            else if (tid < 448) SM[tid] = b_i[n * 64 + tid - 384];
            else SM[tid] = sp[n * 64 + tid - 448];
        }
#pragma unroll
        for (int k = 0; k < 5; ++k) { const int e = tid + 512 * k, j = e >> 3, c8 = e & 7; if (e < 259 * 8) *(LAS u32x4*)(L + RG_XR + j * RG_PITCH + c8 * 16) = xr_reg[k]; }
        if (FINAL) {
#pragma unroll
            for (int k = 0; k < 4; ++k) { const int e = tid + 512 * k, j = e >> 3, c8 = e & 7; *(LAS u32x4*)(L + RG_GR + j * RG_PITCH + c8 * 16) = gr_reg[k]; }
 }
        __syncthreads();
        if (it + F.G < NB * 16 * 8) RG_LOAD(it + F.G);
        { const int c8 = tid & 7; float cw[4][8], cb[8];
#pragma unroll
            for (int i = 0; i < 8; ++i) { cb[i] = SM[256 + c8 * 8 + i];
#pragma unroll
                for (int q = 0; q < 4; ++q) cw[q][i] = SM[q * 64 + c8 * 8 + i]; }
#pragma unroll
            for (int k = 0; k < 4; ++k) { const int j = (tid >> 3) + 64 * k; float xc[8];
#pragma unroll
                for (int i = 0; i < 8; ++i) xc[i] = cb[i];
#pragma unroll
                for (int q = 0; q < 4; ++q) { const u32x4 v = *(const LAS u32x4*)(L + RG_XR + (j + q) * RG_PITCH + c8 * 16);
#pragma unroll
                    for (int e = 0; e < 4; ++e) { xc[2 * e] += cw[q][2 * e] * __uint_as_float(v[e] << 16); xc[2 * e + 1] += cw[q][2 * e + 1] * __uint_as_float(v[e] & 0xffff0000u); } }
                *(LAS u32x4*)(L + RG_XC + j * RG_PITCH + c8 * 16) = (u32x4){pk2(xc[0], xc[1]), pk2(xc[2], xc[3]), pk2(xc[4], xc[5]), pk2(xc[6], xc[7])}; } }
        if (it + F.G < NB * 16 * 8) RG_H0(it + F.G, par ^ 1);
        __syncthreads();
        f32x16 ga[2], gi[2];
#pragma unroll
        for (int cb2 = 0; cb2 < 2; ++cb2) { ga[cb2] = f32x16{}; gi[cb2] = f32x16{}; }
#pragma unroll
        for (int ks = 0; ks < 4; ++ks) { const bf16x8 af = *(const LAS bf16x8*)(L + RG_XC + (32 * w + r32) * RG_PITCH + (16 * ks + 8 * hh) * 2);
#pragma unroll
            for (int cb2 = 0; cb2 < 2; ++cb2) {
                const bf16x8 ba = *(const LAS bf16x8*)(WT + (cb2 * 32 + r32) * RG_PITCH + (16 * ks + 8 * hh) * 2);
                const bf16x8 bi = *(const LAS bf16x8*)(WT + (64 + cb2 * 32 + r32) * RG_PITCH + (16 * ks + 8 * hh) * 2);
                ga[cb2] = __builtin_amdgcn_mfma_f32_32x32x16_bf16(af, ba, ga[cb2], 0, 0, 0);
                gi[cb2] = __builtin_amdgcn_mfma_f32_32x32x16_bf16(af, bi, gi[cb2], 0, 0, 0); } }
        float As[2][4], Hs[2][4];
#pragma unroll
        for (int cb2 = 0; cb2 < 2; ++cb2) { const int d = cb2 * 32 + r32; const float bav = SM[320 + d], biv = SM[384 + d], spv = SM[448 + d];
#pragma unroll
            for (int r = 0; r < 16; ++r) { const int tt = 32 * w + (r & 3) + 8 * (r >> 2) + 4 * hh;
                const float xcv = bf2f(*(const LAS bf16*)(L + RG_XC + tt * RG_PITCH + d * 2));
                const float rg = __builtin_amdgcn_rcpf(1.f + __expf(-(ga[cb2][r] + bav))), ig = __builtin_amdgcn_rcpf(1.f + __expf(-(gi[cb2][r] + biv)));
                const float la = -8.0f * rg * spv; ga[cb2][r] = __expf(la); gi[cb2][r] = __builtin_amdgcn_sqrtf(one_minus_exp(2.f * la)) * (ig * xcv); }
#pragma unroll
            for (int g = 0; g < 4; ++g) { const float a0 = ga[cb2][4 * g], a1 = ga[cb2][4 * g + 1], a2 = ga[cb2][4 * g + 2], a3 = ga[cb2][4 * g + 3];
                As[cb2][g] = (a0 * a1) * (a2 * a3); Hs[cb2][g] = ((gi[cb2][4 * g] * a1 + gi[cb2][4 * g + 1]) * a2 + gi[cb2][4 * g + 2]) * a3 + gi[cb2][4 * g + 3]; } }
        float Ao[2][4], Ho[2][4];
#pragma unroll
        for (int cb2 = 0; cb2 < 2; ++cb2)
#pragma unroll
            for (int g = 0; g < 4; ++g) { Ao[cb2][g] = __shfl_xor(As[cb2][g], 32); Ho[cb2][g] = __shfl_xor(Hs[cb2][g], 32); }
        LAS f32x2* WC = (LAS f32x2*)(L + RG_WC);
        float Ae[2][4], He[2][4], Aod[2][4], Hod[2][4];
#pragma unroll
        for (int cb2 = 0; cb2 < 2; ++cb2) { float Aw = 1.f, Hw = 0.f;
#pragma unroll
            for (int g = 0; g < 4; ++g) { Ae[cb2][g] = hh ? Ao[cb2][g] : As[cb2][g]; He[cb2][g] = hh ? Ho[cb2][g] : Hs[cb2][g]; Aod[cb2][g] = hh ? As[cb2][g] : Ao[cb2][g]; Hod[cb2][g] = hh ? Hs[cb2][g] : Ho[cb2][g];
                Hw = Ae[cb2][g] * Hw + He[cb2][g]; Aw *= Ae[cb2][g]; Hw = Aod[cb2][g] * Hw + Hod[cb2][g]; Aw *= Aod[cb2][g]; }
            if (hh == 0) WC[w * 64 + cb2 * 32 + r32] = (f32x2){Aw, Hw}; }
        __syncthreads();
        float hin[2];
#pragma unroll
        for (int cb2 = 0; cb2 < 2; ++cb2) { const int d = cb2 * 32 + r32; float h = 0.f;
            if (FINAL) h = SM[512 + 64 * par + d];
            for (int w2 = 0; w2 < w; ++w2) { const f32x2 s2 = WC[w2 * 64 + d]; h = s2.x * h + s2.y; }
            hin[cb2] = h;
            if (!FINAL) { if (w == 7 && hh == 0) { float Ac = 1.f, Hc = 0.f;
#pragma unroll
                    for (int w2 = 0; w2 < 8; ++w2) { const f32x2 s2 = WC[w2 * 64 + d]; Hc = s2.x * Hc + s2.y; Ac *= s2.x; }
                    SUMM[((size_t)b * 16 + ck) * 512 + n * 64 + d] = make_float2(Ac, Hc); } } }
        if (FINAL) {
#pragma unroll
            for (int cb2 = 0; cb2 < 2; ++cb2) { const int d = cb2 * 32 + r32; float P = hin[cb2];
#pragma unroll
                for (int g = 0; g < 4; ++g) { const float Po = Ae[cb2][g] * P + He[cb2][g]; float h = hh ? Po : P;
#pragma unroll
                    for (int i = 0; i < 4; ++i) { const int r = 4 * g + i; const int tt = 32 * w + (r & 3) + 8 * (r >> 2) + 4 * hh; h = ga[cb2][r] * h + gi[cb2][r];
                        const float gv = bf2f(*(const LAS bf16*)(L + RG_GR + tt * RG_PITCH + d * 2));
                        *(LAS bf16*)(L + RG_XC + tt * RG_PITCH + d * 2) = (bf16)f2bf(h * gelu_tanh_f(gv)); }
                    P = Aod[cb2][g] * Po + Hod[cb2][g]; } }
            LDS_WAIT(); asm volatile("" ::: "memory");
#pragma unroll
            for (int k = 0; k < 4; ++k) { const int idx = k * 64 + lane, row = idx >> 3, c8 = idx & 7; const u32x4 v = *(const LAS u32x4*)(L + RG_XC + (32 * w + row) * RG_PITCH + c8 * 16);
                float q = 0.f;
#pragma unroll
                for (int e = 0; e < 4; ++e) { const float lo = __uint_as_float(v[e] << 16), hi2 = __uint_as_float(v[e] & 0xffff0000u); q += lo * lo + hi2 * hi2; }
                q += __shfl_xor(q, 1); q += __shfl_xor(q, 2); q += __shfl_xor(q, 4);
                const size_t tok = t0 + 32 * w + row;
                *(u32x4*)(MIX + tok * D + 512 + n * 64 + c8 * 8) = v;
                if (c8 == 0) SSQ[tok * 16 + 8 + n] = q; }
        }
        __syncthreads(); par ^= 1;
    }
#undef RG_LOAD
#undef RG_H0
}
constexpr int P5_WR = 0, P5_LCNT = 81920, P5_LBASE = 81920 + 64, P5_DEC = 81920 + 128;
__device__ __forceinline__ void p5_ln_router(Frame& F, const bf16* PRE, const float* g, const float* bb, bf16* X1, const float* wg, const float* bg, const float* we, const float* be,
                                             gu32* gcnt, int* LIST, uint4* TOK) {
    LAS unsigned char* L = F.lds + RING_OFF; LAS float* WR = (LAS float*)(L + P5_WR); LAS unsigned* lcnt = (LAS unsigned*)(L + P5_LCNT); LAS unsigned* lbase = (LAS unsigned*)(L + P5_LBASE); LAS unsigned* dec = (LAS unsigned*)(L + P5_DEC);
    const int tid = F.tid, lane = F.lane, w = F.wave;
    for (int i = tid; i < 4096; i += 512) WR[(i & 3) * 1024 + (i >> 2)] = wg[i];
    for (int i = tid; i < 16384; i += 512) WR[(4 + (i & 15)) * 1024 + (i >> 4)] = we[i];
    float gg[16], gb[16];
#pragma unroll
    for (int j = 0; j < 2; ++j)
#pragma unroll
        for (int q = 0; q < 2; ++q) { const f32x4 a = *(const f32x4*)(g + j * 512 + lane * 8 + q * 4), c = *(const f32x4*)(bb + j * 512 + lane * 8 + q * 4);
#pragma unroll
            for (int e = 0; e < 4; ++e) { gg[j * 8 + q * 4 + e] = a[e]; gb[j * 8 + q * 4 + e] = c[e]; } }
    float bias[20];
#pragma unroll
    for (int o = 0; o < 4; ++o) bias[o] = bg[o];
#pragma unroll
    for (int o = 0; o < 16; ++o) bias[4 + o] = be[o];
    for (int rb = F.vcu; rb < T / 128; rb += F.G) {
        if (tid < 16) lcnt[tid] = 0u;
        __syncthreads();
        for (int i = 0; i < 16; ++i) { const int rl = w * 16 + i; const size_t t = (size_t)rb * 128 + rl;
            float v[16]; float s = 0.f;
#pragma unroll
            for (int j = 0; j < 2; ++j) { const u32x4 raw = *(const u32x4*)(PRE + t * D + j * 512 + lane * 8);
#pragma unroll
                for (int e = 0; e < 4; ++e) { v[j * 8 + 2 * e] = __uint_as_float(raw[e] << 16); v[j * 8 + 2 * e + 1] = __uint_as_float(raw[e] & 0xffff0000u); } }
#pragma unroll
            for (int e = 0; e < 16; ++e) s += v[e];
            const float mu = wave_sum(s) * (1.f / 1024.f); float q = 0.f;
#pragma unroll
            for (int e = 0; e < 16; ++e) { v[e] -= mu; q += v[e] * v[e]; }
            const float rstd = rsqrtf(wave_sum(q) * (1.f / 1024.f) + LN_EPS);
#pragma unroll
            for (int e = 0; e < 16; ++e) v[e] = v[e] * rstd * gg[e] + gb[e];
#pragma unroll
            for (int j = 0; j < 2; ++j) *(u32x4*)(X1 + t * D + j * 512 + lane * 8) = (u32x4){pk2(v[j * 8], v[j * 8 + 1]), pk2(v[j * 8 + 2], v[j * 8 + 3]), pk2(v[j * 8 + 4], v[j * 8 + 5]), pk2(v[j * 8 + 6], v[j * 8 + 7])};
            float lg[20];
#pragma unroll
            for (int o = 0; o < 20; ++o) { float a = 0.f;
#pragma unroll
                for (int j = 0; j < 2; ++j)
#pragma unroll
                    for (int q2 = 0; q2 < 2; ++q2) { const f32x4 wv = *(const LAS f32x4*)(WR + o * 1024 + j * 512 + lane * 8 + q2 * 4);
#pragma unroll
                        for (int e = 0; e < 4; ++e) a += v[j * 8 + q2 * 4 + e] * wv[e]; }
                lg[o] = a; }
#pragma unroll
            for (int o = 0; o < 20; ++o) lg[o] = wave_sum(lg[o]) + bias[o];
            int gi = 0; float gv = lg[0];
#pragma unroll
            for (int o = 1; o < 4; ++o) if (lg[o] > gv) { gi = o; gv = lg[o]; }
            float gs = 0.f;
#pragma unroll
            for (int o = 0; o < 4; ++o) gs += __expf(lg[o] - gv);
            const float gp = 1.f / gs; float l4[4];
#pragma unroll
            for (int o = 0; o < 4; ++o) l4[o] = gi == 0 ? lg[4 + o] : gi == 1 ? lg[8 + o] : gi == 2 ? lg[12 + o] : lg[16 + o];
            int e0 = 0; float v0 = l4[0];
#pragma unroll
            for (int o = 1; o < 4; ++o) if (l4[o] > v0) { e0 = o; v0 = l4[o]; }
            int e1 = -1; float v1 = -INFINITY;
#pragma unroll
            for (int o = 0; o < 4; ++o) if (o != e0 && (e1 < 0 || l4[o] > v1)) { e1 = o; v1 = l4[o]; }
            const float p1 = __expf(v1 - v0), w0 = gp / (1.f + p1), w1 = gp * p1 / (1.f + p1);
            if (lane == 0) { const unsigned E0 = gi * 4 + e0, E1 = gi * 4 + e1;
                const unsigned q0 = atomicAdd((unsigned*)&lcnt[E0], 1u), q1 = atomicAdd((unsigned*)&lcnt[E1], 1u);
                dec[rl * 6 + 0] = E0; dec[rl * 6 + 1] = E1; dec[rl * 6 + 2] = q0; dec[rl * 6 + 3] = q1; dec[rl * 6 + 4] = __float_as_uint(w0); dec[rl * 6 + 5] = __float_as_uint(w1); }
        }
        __syncthreads();
        if (tid < 16) lbase[tid] = __hip_atomic_fetch_add(gcnt + tid, lcnt[tid], RLX_AGENT);
        __syncthreads();
        if (tid < 128) { const int t = rb * 128 + tid; const unsigned E0 = dec[tid * 6], E1 = dec[tid * 6 + 1], p0 = lbase[E0] + dec[tid * 6 + 2], p1 = lbase[E1] + dec[tid * 6 + 3];
            LIST[(size_t)E0 * T + p0] = t; LIST[(size_t)E1 * T + p1] = t; TOK[t] = make_uint4((E0 << 24) | p0, (E1 << 24) | p1, dec[tid * 6 + 4], dec[tid * 6 + 5]); }
        __syncthreads();
    }
}
__device__ __forceinline__ void moe_tile_bases(Frame& F, const gu32* gcnt) {
    LAS unsigned* TB = (LAS unsigned*)(F.lds + TAB_TB);
    if (F.tid == 0) { unsigned acc = 0u; for (int e = 0; e < 16; ++e) { TB[e] = acc; const unsigned c = __hip_atomic_load(gcnt + e, RLX_AGENT); TB[32 + e] = c; acc += (c + 255u) >> 8; } TB[16] = acc; }
    __syncthreads();
}
__device__ __forceinline__ void p8_combine_ln(Frame& F, const bf16* X1, const bf16* Y, const uint4* TOK, const float* g, const float* bb, bf16* XBo, float* outf) {
    const LAS unsigned* TB = (const LAS unsigned*)(F.lds + TAB_TB); const int lane = F.lane;
    float gg[16], gb[16];
#pragma unroll
    for (int j = 0; j < 2; ++j)
#pragma unroll
        for (int q = 0; q < 2; ++q) { const f32x4 a = *(const f32x4*)(g + j * 512 + lane * 8 + q * 4), c = *(const f32x4*)(bb + j * 512 + lane * 8 + q * 4);
#pragma unroll
            for (int e = 0; e < 4; ++e) { gg[j * 8 + q * 4 + e] = a[e]; gb[j * 8 + q * 4 + e] = c[e]; } }
    const int gw = F.vcu * NWAVES + F.wave, NGW = F.G * NWAVES;
    for (int t = gw; t < T; t += NGW) {
        const uint4 ti = TOK[t]; const size_t s0 = (size_t)TB[ti.x >> 24] * 256 + (ti.x & 0xffffffu), s1 = (size_t)TB[ti.y >> 24] * 256 + (ti.y & 0xffffffu);
        const float w0 = __uint_as_float(ti.z), w1 = __uint_as_float(ti.w);
        float v[16]; float s = 0.f;
#pragma unroll
        for (int j = 0; j < 2; ++j) { const u32x4 a = *(const u32x4*)(X1 + (size_t)t * D + j * 512 + lane * 8), y0 = *(const u32x4*)(Y + s0 * D + j * 512 + lane * 8), y1 = *(const u32x4*)(Y + s1 * D + j * 512 + lane * 8);
#pragma unroll
            for (int e = 0; e < 4; ++e) { v[j * 8 + 2 * e] = ALPHA * __uint_as_float(a[e] << 16) + w0 * __uint_as_float(y0[e] << 16) + w1 * __uint_as_float(y1[e] << 16);
                v[j * 8 + 2 * e + 1] = ALPHA * __uint_as_float(a[e] & 0xffff0000u) + w0 * __uint_as_float(y0[e] & 0xffff0000u) + w1 * __uint_as_float(y1[e] & 0xffff0000u); } }
#pragma unroll
        for (int e = 0; e < 16; ++e) s += v[e];
        const float mu = wave_sum(s) * (1.f / 1024.f); float q = 0.f;
#pragma unroll
        for (int e = 0; e < 16; ++e) { v[e] -= mu; q += v[e] * v[e]; }
        const float rstd = rsqrtf(wave_sum(q) * (1.f / 1024.f) + LN_EPS);
#pragma unroll
        for (int e = 0; e < 16; ++e) v[e] = v[e] * rstd * gg[e] + gb[e];
        if (outf) {
#pragma unroll
            for (int j = 0; j < 2; ++j)
#pragma unroll
                for (int q2 = 0; q2 < 2; ++q2) *(f32x4*)(outf + (size_t)t * D + j * 512 + lane * 8 + q2 * 4) = (f32x4){v[j * 8 + q2 * 4], v[j * 8 + q2 * 4 + 1], v[j * 8 + q2 * 4 + 2], v[j * 8 + q2 * 4 + 3]};
        } else {
#pragma unroll
            for (int j = 0; j < 2; ++j) *(u32x4*)(XBo + (size_t)t * D + j * 512 + lane * 8) = (u32x4){pk2(v[j * 8], v[j * 8 + 1]), pk2(v[j * 8 + 2], v[j * 8 + 3]), pk2(v[j * 8 + 4], v[j * 8 + 5]), pk2(v[j * 8 + 6], v[j * 8 + 7])};
        }
    }
}
constexpr int N_PHASES = 17;
__global__ void __launch_bounds__(NWAVES * 64, 2) mega_fwd(Args args) {
    extern __shared__ __attribute__((aligned(16))) unsigned char lds[];
    Frame F;
    F.lds = (LAS unsigned char*)lds; F.lds_gen = lds;
    F.MISC = (volatile LAS unsigned*)(F.lds + MISC_OFF);
    F.tid = threadIdx.x; F.lane = F.tid & 63; F.wave = __builtin_amdgcn_readfirstlane(F.tid >> 6);
    F.G = gridDim.x; { const int bx = blockIdx.x; F.vcu = (F.G % 8 == 0) ? (bx % 8) * (F.G / 8) + bx / 8 : bx; }
    F.ctl = (gu32*)(args.ws + WS_CTL);
    for (int u = F.tid; u < (LDS_BYTES - LDSCTL_OFF) / 4; u += NWAVES * 64) ((LAS unsigned*)(F.lds + LDSCTL_OFF))[u] = 0u;
    __syncthreads();
    const int lo = args.ph_lo, hi = args.ph_hi;
    const bool multi = (hi - lo) > 1;
    XcdBarrier bar; bar.bar = (unsigned*)(F.ctl + CW_BAR); bar.x = 0; bar.st = nullptr;
    if (multi) bar = xcd_barrier_post((unsigned*)(F.ctl + CW_BAR), F.MISC + 8);
#ifndef MK_CM
#define MK_CM 0x1FF
#endif
#define IN(k) (lo <= (k) && (k) < hi)
#define INK(r) (((MK_CM >> ((r) + 1)) & 1) && IN(p + (r)))
#define SEAM(k) do { if (IN((k) + 1)) xcd_barrier(bar); } while (0)
#define PHASE_BEGIN() const __attribute__((address_space(4))) Args* ka; { const __attribute__((address_space(4))) Args* k_ = (const __attribute__((address_space(4))) Args*)__builtin_amdgcn_kernarg_segment_ptr(); asm volatile("" : "+s"(k_)); ka = k_; } \
    unsigned char* const ws = ka->ws; { int t_ = threadIdx.x; asm volatile("" : "+v"(t_)); F.tid = t_; F.lane = t_ & 63; F.wave = __builtin_amdgcn_readfirstlane(t_ >> 6); } \
    int bx; { int b_ = blockIdx.x; asm volatile("" : "+s"(b_)); bx = b_; F.vcu = (F.G % 8 == 0) ? (bx % 8) * (F.G / 8) + bx / 8 : bx; } (void)bx; \
    bf16* const XB = (bf16*)(ws + WS_XB); bf16* const PROJ = (bf16*)(ws + WS_PROJ); bf16* const MIX = (bf16*)(ws + WS_MIX); bf16* const PRE = (bf16*)(ws + WS_PRE); \
    bf16* const X1 = (bf16*)(ws + WS_X1); bf16* const Hb = (bf16*)(ws + WS_H); bf16* const Yb = (bf16*)(ws + WS_Y); bf16* const KM = (bf16*)(ws + WS_KM); \
    float* const SSQ = (float*)(ws + WS_SSQ); uint4* const TOK = (uint4*)(ws + WS_TOK); int* const LIST = (int*)(ws + WS_LIST); float2* const SUMM = (float2*)(ws + WS_SUMM); \
    (void)XB; (void)PROJ; (void)MIX; (void)PRE; (void)X1; (void)Hb; (void)Yb; (void)KM; (void)SSQ; (void)TOK; (void)LIST; (void)SUMM;

    if ((MK_CM & 1) && IN(0)) { PHASE_BEGIN(); p0_prologue(F, ka); SEAM(0); }

#pragma nounroll
    for (int l = 0; l < 2; ++l) {
        const int p = 1 + 8 * l;
        if (INK(0)) { PHASE_BEGIN();
            DenseOrder S; S.init(XB, (const bf16*)(ws + WS_WIN) + (size_t)l * NPROJ * D, T, NPROJ, D, F.G, bx);
            { const f32x2* rope = (const f32x2*)(ws + WS_ROPE); LAS f32x2* RB = (LAS f32x2*)(F.lds + TAB_OFF); LAS f32x2* RA = (LAS f32x2*)(F.lds + TAB_OFF + 16384);
#pragma unroll
                for (int k2 = 0; k2 < 4; ++k2) RB[F.tid + 512 * k2] = rope[F.tid + 512 * k2];
                if (F.tid < 128) RA[F.tid] = rope[(size_t)(F.tid >> 3) * 2048 + (F.tid & 7)];
                __syncthreads(); }
            EpiProj E{PROJ, (const LAS f32x4*)(F.lds + TAB_OFF), (const LAS f32x4*)(F.lds + TAB_OFF + 16384)};
            gemm_phase<EpiProj, DenseOrder, false, false>(F.lds + RING_OFF, D, S, E, nullptr);
            SEAM(p);
        }
        if (INK(1)) { PHASE_BEGIN();
            if (!(args.skip & 1)) for (int it = F.vcu; it < NB * NBLK; it += F.G) kmean_item(F, it, PROJ, KM);
            if (!(args.skip & 2)) { rglru_phase<false>(F, PROJ, ka->in[2] + l * 2048, ka->in[3] + l * 512, (const bf16*)(ws + WS_WRG) + (size_t)l * 65536, ka->in[5] + l * 512, ka->in[7] + l * 512, (const float*)(ws + WS_SP) + l * 512, SUMM, MIX, SSQ); }
            SEAM(p + 1);
        }
        if (INK(2)) { PHASE_BEGIN();
            if (!((MK_CM >> 9) & 1) && !(args.skip & 4)) { const attn_body::AttnTensors AT{PROJ + QOFF, PROJ + KOFF, PROJ + VOFF, MIX, KM, SSQ};
                const attn_body::StaticOrder S((int)F.G, bx);
                attn_body::attn_phase<attn_body::StaticOrder>((char*)lds + RING_OFF, AT, S); }
            if (!((MK_CM >> 10) & 1) && !(args.skip & 8)) { rglru_phase<true>(F, PROJ, ka->in[2] + l * 2048, ka->in[3] + l * 512, (const bf16*)(ws + WS_WRG) + (size_t)l * 65536, ka->in[5] + l * 512, ka->in[7] + l * 512, (const float*)(ws + WS_SP) + l * 512, SUMM, MIX, SSQ); }
            SEAM(p + 2);
        }
        if (INK(3)) { PHASE_BEGIN();
            DenseOrder S; S.init(MIX, (const bf16*)(ws + WS_WOUT) + (size_t)l * D * D, T, D, D, F.G, bx);
            EpiOut E{PRE, XB, SSQ, (LAS f32x2*)(F.lds + TAB_RS)};
            gemm_phase<EpiOut, DenseOrder, false, true>(F.lds + RING_OFF, D, S, E, nullptr);
            SEAM(p + 3);
        }
        if (INK(4)) { PHASE_BEGIN();
            p5_ln_router(F, PRE, ka->in[12] + l * D, ka->in[13] + l * D, X1, ka->in[14] + l * 4096, ka->in[15] + l * 4, ka->in[16] + l * 16384, ka->in[17] + l * 16, F.ctl + CW_CNT + 64 * l, LIST, TOK);
            SEAM(p + 4);
        }
        if (INK(5)) { PHASE_BEGIN();
            moe_tile_bases(F, F.ctl + CW_CNT + 64 * l);
            const LAS unsigned* TB = (const LAS unsigned*)(F.lds + TAB_TB); LAS unsigned* GI = (LAS unsigned*)(F.lds + TAB_GIDX);
            MoeOrder S{TB, F.G, bx, (const char*)X1, (const char*)((const bf16*)(ws + WS_WGU) + (size_t)l * 16 * 1024 * D), 0, (size_t)1024 * D * 2, (size_t)256 * D * 2, 128, true};
            { Unit u; for (int i = 0; i < 6 && S.next(i, u); ++i) { if (F.tid < 256) { const int mtg = u.orow >> 8; int e = 0;
#pragma unroll
                        for (int j = 1; j < 16; ++j) e += ((int)TB[j] <= mtg) ? 1 : 0;
                        const int pos = (mtg - (int)TB[e]) * 256 + F.tid; const int cn = (int)TB[32 + e];
                        GI[i * 256 + F.tid] = (unsigned)LIST[(size_t)e * T + (pos < cn ? pos : 0)]; } } }
            __syncthreads();
            EpiSwiglu E{Hb};
            gemm_phase<EpiSwiglu, MoeOrder, true, false>(F.lds + RING_OFF, D, S, E, GI);
            SEAM(p + 5);
        }
        if (INK(6)) { PHASE_BEGIN();
            moe_tile_bases(F, F.ctl + CW_CNT + 64 * l);
            const LAS unsigned* TB = (const LAS unsigned*)(F.lds + TAB_TB);
            MoeOrder S{TB, F.G, bx, (const char*)Hb, (const char*)((const bf16*)(ws + WS_WD) + (size_t)l * 16 * D * DEXP), (size_t)256 * DEXP * 2, (size_t)D * DEXP * 2, (size_t)256 * DEXP * 2, 256, false};
            EpiPlain E{Yb, D};
            gemm_phase<EpiPlain, MoeOrder, false, false>(F.lds + RING_OFF, DEXP, S, E, nullptr);
            SEAM(p + 6);
        }
        if (INK(7)) { PHASE_BEGIN();
            moe_tile_bases(F, F.ctl + CW_CNT + 64 * l);
            p8_combine_ln(F, X1, Yb, TOK, ka->in[21] + l * D, ka->in[22] + l * D, XB, l == 1 ? ka->out : nullptr);
            if (l == 0) SEAM(p + 7);
        }
    }
#undef IN
#undef PHASE_BEGIN
#undef INK
#undef SEAM
}
}
#ifndef MK_IMPL
#define MK_IMPL 0x1FFFF
#endif
#ifndef MK_PARTS
#define MK_PARTS 7
#endif
#ifndef MK_REPEAT
#define MK_REPEAT 0
#endif
#ifndef MK_RSKIP
#define MK_RSKIP 0
#endif
#ifndef MK_FUSE
#define MK_FUSE 1
#endif
struct Ptrs { const float* in[23]; };
static void nb_phase(int ph, const Ptrs& P, float* d_out, unsigned char* ws, hipStream_t st, int parts) {
    using namespace cfg;
    bf16* XB = (bf16*)(ws + WS_XB); bf16* PROJ = (bf16*)(ws + WS_PROJ); bf16* MIX = (bf16*)(ws + WS_MIX); bf16* PRE = (bf16*)(ws + WS_PRE);
    bf16* X1 = (bf16*)(ws + WS_X1); bf16* Hb = (bf16*)(ws + WS_H); bf16* Yb = (bf16*)(ws + WS_Y); bf16* KM = (bf16*)(ws + WS_KM);
    float* SSQ = (float*)(ws + WS_SSQ); uint4* TOK = (uint4*)(ws + WS_TOK); int* LIST = (int*)(ws + WS_LIST); unsigned* CTL = (unsigned*)(ws + WS_CTL);
    if (ph == 0) { nb::x_to_bf16<<<(T * D / 4 + 255) / 256, 256, 0, st>>>(P.in[0], XB); return; }
    const int l = (ph - 1) / 8, k = (ph - 1) % 8; unsigned* cnt = CTL + CW_CNT + 64 * l;
    switch (k) {
    case 0: nb::gemm<0><<<dim3(NPROJ / 64, T / 64), 256, 0, st>>>(XB, D, nullptr, nullptr, 0, T, P.in[1] + (size_t)l * D * NPROJ, nullptr, NPROJ, PROJ, NPROJ, D, nullptr, nullptr, nullptr, nullptr);
            nb::rope_scale<<<(T * 1024) / 256, 256, 0, st>>>(PROJ); break;
    case 1: if (!(parts & 1)) nb::kmean<<<(NB * NH * NBLK * HD) / 256, 256, 0, st>>>(PROJ, KM); break;
    case 2: { if (!(parts & 4)) nb::attn<<<T * NH, 64, 0, st>>>(PROJ, KM, MIX);
            if (!(parts & 2)) { float* Aa = d_out; float* U = d_out + (size_t)T * 512;
                nb::rglru_gates<<<T * 8, 64, 0, st>>>(PROJ, P.in[2] + l * 2048, P.in[3] + l * 512, P.in[4] + l * 32768, P.in[5] + l * 512, P.in[6] + l * 32768, P.in[7] + l * 512, P.in[8] + l * 512, Aa, U);
                nb::rglru_scan<<<(NB * 512) / 256, 256, 0, st>>>(Aa, U, PROJ, MIX); }
            if ((parts & 6) != 6) nb::ssq_groups<<<(T * 16) / 256, 256, 0, st>>>(MIX, SSQ); } break;
    case 3: nb::gemm<3><<<dim3(D / 64, T / 64), 256, 0, st>>>(MIX, D, nullptr, nullptr, 0, T, P.in[11] + (size_t)l * D * D, nullptr, D, PRE, D, D, SSQ, P.in[9] + l * 512, P.in[10] + l * 512, XB); break;
    case 4: nb::ln_router<<<T / 4, 256, 0, st>>>(PRE, P.in[12] + l * D, P.in[13] + l * D, X1, P.in[14] + l * 4096, P.in[15] + l * 4, P.in[16] + l * 16384, P.in[17] + l * 16, cnt, LIST, TOK); break;
    case 5: for (int e = 0; e < 16; ++e) nb::gemm<1><<<dim3(512 / 64, T / 64), 256, 0, st>>>(X1, D, LIST, cnt, e, T, P.in[18] + ((size_t)l * 16 + e) * D * 512, P.in[19] + ((size_t)l * 16 + e) * D * 512, 512, Hb, 512, D, nullptr, nullptr, nullptr, nullptr); break;
    case 6: for (int e = 0; e < 16; ++e) nb::gemm<0><<<dim3(D / 64, T / 64), 256, 0, st>>>(Hb, 512, nullptr, cnt, e, T, P.in[20] + ((size_t)l * 16 + e) * 512 * D, nullptr, D, Yb, D, 512, nullptr, nullptr, nullptr, nullptr); break;
    case 7: nb::combine_ln<<<T / 4, 256, 0, st>>>(X1, Yb, TOK, cnt, P.in[21] + l * D, P.in[22] + l * D, XB, l == 1 ? d_out : nullptr); break;
    }
}
extern "C" void kernel_launch(void* const* d_in, const int* in_sizes, int n_in, void* d_out, int out_size, void* d_ws, size_t ws_size, hipStream_t stream) {
    static int grid = 0;
    if (grid == 0) {
        if (n_in != 23 || in_sizes[0] != cfg::T * cfg::D || out_size != cfg::T * cfg::D || ws_size < cfg::WS_END) { fprintf(stderr, "kernel_launch: unexpected problem (n_in %d, ws %zu)\n", n_in, ws_size); grid = -1; return; }
        int dev = 0, cus = 0, per_cu = 0;
        if (hipGetDevice(&dev) != hipSuccess || hipDeviceGetAttribute(&cus, hipDeviceAttributeMultiprocessorCount, dev) != hipSuccess) { grid = -1; return; }
        if (hipFuncSetAttribute((const void*)mk::mega_fwd, hipFuncAttributeMaxDynamicSharedMemorySize, mk::LDS_BYTES) != hipSuccess) { fprintf(stderr, "kernel_launch: hipFuncSetAttribute failed\n"); grid = -1; return; }
        if (hipOccupancyMaxActiveBlocksPerMultiprocessor(&per_cu, (const void*)mk::mega_fwd, mk::NWAVES * 64, mk::LDS_BYTES) != hipSuccess || per_cu < 1) { fprintf(stderr, "kernel_launch: occupancy query says %d blocks per CU\n", per_cu); }
        (void)hipGetLastError();
        grid = cus;
    }
    if (grid < 0) return;
    Ptrs P; for (int i = 0; i < 23; ++i) P.in[i] = (const float*)d_in[i];
    unsigned char* ws = (unsigned char*)d_ws;
    (void)hipMemsetAsync(ws + cfg::WS_CTL, 0, cfg::CTL_ZERO_BYTES, stream);
    mk::Args a{}; for (int i = 0; i < 23; ++i) a.in[i] = P.in[i]; a.out = (float*)d_out; a.ws = ws; a.skip = (~MK_PARTS) & 7; a.skip = (a.skip & 1) | ((a.skip & 2) ? (2 | 8) : 0) | ((a.skip & 4) ? 4 : 0); a.pad = 0;
    int i = 0;
    while (i < mk::N_PHASES) {
        const bool mega = (MK_IMPL >> i) & 1;
        const int k = (i - 1) % 8;
        if (!mega) { nb_phase(i, P, (float*)d_out, ws, stream, 0); ++i; continue; }
        int j = i + 1;
        const bool mixed_here = (i > 0) && (k == 1 || k == 2) && (MK_PARTS != 7);
        if (MK_FUSE && !mixed_here) while (j < mk::N_PHASES && ((MK_IMPL >> j) & 1) && !(((j - 1) % 8 == 1 || (j - 1) % 8 == 2) && MK_PARTS != 7)) ++j;
        a.ph_lo = i; a.ph_hi = j;
        if (!(mixed_here && MK_PARTS == 0)) for (int rep = 0; rep <= ((!MK_FUSE && ((MK_REPEAT >> i) & 1)) ? 1 : 0); ++rep) { mk::Args a2 = a; if (rep) a2.skip |= MK_RSKIP; hipLaunchKernelGGL(mk::mega_fwd, dim3(grid), dim3(mk::NWAVES * 64), mk::LDS_BYTES, stream, a2); }
        if (mixed_here) nb_phase(i, P, (float*)d_out, ws, stream, MK_PARTS);
        i = j;
    }
}
```
